# Optimizing an MI355X kernel written in HIP

```python
import math
import jax, jax.numpy as jnp
from jax import lax
import numpy as np

D_MODEL = 1024
BATCH = 2
SEQ = 8192
DEPTH = 2
DEC_BATCH = 128
DEC_SEQ = 1
PAST_LEN = 16384
PAGE_SIZE = 128

HEAD_DIM = 64
H_A = 8
KV_A = 2
G_A = H_A // KV_A
D_A = H_A * HEAD_DIM
WINDOW = 128
ROT_DIM = HEAD_DIM // 4
ROPE_THETA = 500000.0
G_B = 4
D_B = G_B * HEAD_DIM
CHUNK_B = 128
H_C = 4
DK_C = 64
DV_C = 64
D_C = H_C * DV_C
CHUNK_C = 32
D_MIX = D_A + D_B + D_C
IN_SIZES = (D_A, KV_A * HEAD_DIM, KV_A * HEAD_DIM, D_B, D_B, H_C * DK_C, H_C * DK_C, D_C, D_C)
D_IN = 2304
D_FF = 2816
ALPHA = (2 * DEPTH) ** 0.25
BETA = (8 * DEPTH) ** -0.25
LN_EPS = 1e-5
RMS_EPS = 1e-6
NEG_BIG = -1e30
N_MOD = 9

kernel_name = 'hymba_swa_gmlp_hgrn2_macaron_deepnorm_step'


def layer_norm(x, g, b):
    xf = x.astype(jnp.float32)
    mu = jnp.mean(xf, axis=-1, keepdims=True)
    var = jnp.mean(jnp.square(xf - mu), axis=-1, keepdims=True)
    return ((xf - mu) * lax.rsqrt(var + LN_EPS) * g.astype(jnp.float32) + b.astype(jnp.float32)).astype(x.dtype)


def rms_norm(x, g):
    xf = x.astype(jnp.float32)
    return xf * lax.rsqrt(jnp.mean(jnp.square(xf), axis=-1, keepdims=True) + RMS_EPS) * g.astype(jnp.float32)


def modulate(x, shift, scale):
    return x * (1 + scale) + shift


def post_norm(x, y, gate, g, b):
    return layer_norm(ALPHA * x + (1 + gate) * y, g, b)


def swiglu(h, w_in, w_out):
    a, g = jnp.split(h @ w_in, 2, axis=-1)
    return (jax.nn.silu(g) * a) @ w_out


def rope(x, pos):
    half = ROT_DIM // 2
    inv = ROPE_THETA ** (-jnp.arange(half, dtype=jnp.float32) * 2.0 / ROT_DIM)
    ang = pos.astype(jnp.float32)[:, None] * inv[None, :]
    cos = jnp.cos(ang)[None, :, None, :]
    sin = jnp.sin(ang)[None, :, None, :]
    xr = x[..., :ROT_DIM].astype(jnp.float32)
    x1, x2 = xr[..., :half], xr[..., half:]
    rot = jnp.concatenate([x1 * cos - x2 * sin, x2 * cos + x1 * sin], axis=-1)
    return jnp.concatenate([rot.astype(x.dtype), x[..., ROT_DIM:]], axis=-1)


def sink_probs(s, sink):
    sk = jnp.broadcast_to(sink.astype(jnp.float32).reshape(KV_A, G_A, 1, 1), s.shape[:-1] + (1,))
    return jax.nn.softmax(jnp.concatenate([s, sk], axis=-1), axis=-1)[..., :-1]


def swa_prompt(q, k, v, sink):
    B, T = q.shape[:2]
    nb = T // WINDOW
    qb = q.reshape(B, nb, WINDOW, KV_A, G_A, HEAD_DIM)

    def with_prev(t):
        t = t.reshape(B, nb, WINDOW, KV_A, HEAD_DIM)
        prev = jnp.pad(t, ((0, 0), (1, 0), (0, 0), (0, 0), (0, 0)))[:, :-1]
        return jnp.concatenate([prev, t], axis=2)

    kk, vv = with_prev(k), with_prev(v)
    s = jnp.einsum('bnqkgd,bnskd->bnkgqs', qb, kk, preferred_element_type=jnp.float32) * (HEAD_DIM ** -0.5)
    qi = jnp.arange(WINDOW)[:, None] + WINDOW
    kj = jnp.arange(2 * WINDOW)[None, :]
    band = (kj <= qi) & (qi - kj < WINDOW)
    mask = band[None] & ((jnp.arange(nb)[:, None, None] > 0) | (kj >= WINDOW)[None])
    s = jnp.where(mask[None, :, None, None], s, NEG_BIG)
    p = sink_probs(s, sink)
    o = jnp.einsum('bnkgqs,bnskd->bnqkgd', p.astype(vv.dtype), vv)
    return o.reshape(B, T, D_A)


def swa_sample(q, k, v, sink, k_cache, v_cache):
    B, T = q.shape[:2]
    W = k_cache.shape[1]
    kk = jnp.concatenate([k_cache.astype(k.dtype), k], axis=1)
    vv = jnp.concatenate([v_cache.astype(v.dtype), v], axis=1)
    qpos = PAST_LEN + jnp.arange(T)
    kpos = PAST_LEN - W + jnp.arange(W + T)
    mask = (kpos[None, :] <= qpos[:, None]) & (qpos[:, None] - kpos[None, :] < WINDOW)
    qh = q.reshape(B, T, KV_A, G_A, HEAD_DIM)
    s = jnp.einsum('btkgd,bskd->bkgts', qh, kk, preferred_element_type=jnp.float32) * (HEAD_DIM ** -0.5)
    s = jnp.where(mask, s, NEG_BIG)
    p = sink_probs(s, sink)
    o = jnp.einsum('bkgts,bskd->btkgd', p.astype(vv.dtype), vv)
    return o.reshape(B, T, D_A)


def spatial_gate(u, v, ws, bs):
    B, T = u.shape[:2]
    Tp = -(-T // CHUNK_B) * CHUNK_B
    vp = jnp.pad(v, ((0, 0), (0, Tp - T), (0, 0))).reshape(B, Tp // CHUNK_B, CHUNK_B, G_B, HEAD_DIM)
    causal = jnp.tril(jnp.ones((CHUNK_B, CHUNK_B), dtype=bool))
    wm = jnp.where(causal[None], ws, 0)
    mixed = jnp.einsum('gts,bnsgc->bntgc', wm, vp) + bs.T[None, None, :, :, None]
    mixed = mixed.reshape(B, Tp, D_B)[:, :T]
    return u * mixed


def hgrn2(q, lf, k, i, S0):
    B, T = q.shape[:2]
    L = min(CHUNK_C, T)
    Tp = -(-T // L) * L

    def chunks(t):
        t = jnp.pad(t, ((0, 0), (0, Tp - T), (0, 0), (0, 0)))
        return t.reshape(B, Tp // L, L, H_C, t.shape[-1]).transpose(1, 0, 3, 2, 4)

    causal = jnp.tril(jnp.ones((L, L), dtype=bool))[:, :, None]

    def step(S, xs):
        qc, lfc, kc, ic = xs
        b = jnp.cumsum(lfc, axis=2)
        inter = jnp.einsum('bhtk,bhkv->bhtv', qc * jnp.exp(b), S)
        diff = b[:, :, :, None, :] - b[:, :, None, :, :]
        decay = jnp.where(causal, jnp.exp(jnp.where(causal, diff, 0.0)), 0.0)
        att = jnp.einsum('bhtk,bhsk,bhtsk->bhts', qc, kc, decay)
        o = inter + jnp.einsum('bhts,bhsv->bhtv', att, ic)
        bl = b[:, :, -1]
        S = jnp.exp(bl)[..., None] * S + jnp.einsum('bhsk,bhsv->bhkv', kc * jnp.exp(bl[:, :, None] - b), ic)
        return S, o

    S, o = lax.scan(step, S0, (chunks(q), chunks(lf), chunks(k), chunks(i)))
    o = o.transpose(1, 0, 3, 2, 4).reshape(B, Tp, H_C, DV_C)[:, :T]
    return o, S


def trunk(x, c, positions, k_cache, v_cache, s_cache, w_in, w_out, attn_sinks, gmlp_ln_g, gmlp_ln_b,
          gmlp_ws, gmlp_bs, hgrn_lb, hgrn_norm_g, ffn1_in, ffn1_out, ffn2_in, ffn2_out, ada_w, ada_b,
          ln_g, ln_b):
    sample = k_cache is not None
    B, T = x.shape[:2]
    idx = [int(n) for n in np.cumsum(IN_SIZES)[:-1]]
    P = jax.nn.softmax(hgrn_lb.astype(jnp.float32), axis=0)
    lb_all = jnp.cumsum(P, axis=0) - P[0]
    ks_, vs_, gs_, ss_ = [], [], [], []
    for l in range(DEPTH):
        m = jnp.split((jax.nn.silu(c) @ ada_w[l] + ada_b[l])[:, None, :], N_MOD, axis=-1)
        x = post_norm(x, 0.5 * swiglu(modulate(x, m[0], m[1]), ffn1_in[l], ffn1_out[l]), m[2], ln_g[l, 0], ln_b[l, 0])
        h = modulate(x, m[3], m[4])
        q, k, v, u, gv, cq, cf, ci, cg = jnp.split(h @ w_in[l], idx, axis=-1)
        q = rope(q.reshape(B, T, H_A, HEAD_DIM), positions)
        k = rope(k.reshape(B, T, KV_A, HEAD_DIM), positions)
        v = v.reshape(B, T, KV_A, HEAD_DIM)
        if sample:
            o_a = swa_sample(q, k, v, attn_sinks[l], k_cache[l], v_cache[l])
            ks_.append(k)
            vs_.append(v)
            S0 = s_cache[l].astype(jnp.float32)
        else:
            o_a = swa_prompt(q, k, v, attn_sinks[l])
            wb = min(WINDOW, T)
            ks_.append(k[:, T - wb:])
            vs_.append(v[:, T - wb:])
            S0 = jnp.zeros((B, H_C, DK_C, DV_C), jnp.float32)
        vn = layer_norm(gv, gmlp_ln_g[l], gmlp_ln_b[l])
        o_b = spatial_gate(u, vn, gmlp_ws[l], gmlp_bs[l])
        if sample:
            gs_.append(vn)
        lb = lb_all[l]
        f = lb + (1.0 - lb) * jax.nn.sigmoid(cf.astype(jnp.float32))
        log_f = jnp.log(f).reshape(B, T, H_C, DK_C)
        key_c = (1.0 - f).reshape(B, T, H_C, DK_C)
        o_c, S = hgrn2(cq.reshape(B, T, H_C, DK_C).astype(jnp.float32), log_f, key_c,
                       ci.reshape(B, T, H_C, DV_C).astype(jnp.float32), S0)
        ss_.append(S)
        o_c = rms_norm(o_c, hgrn_norm_g[l]) * jax.nn.silu(cg.reshape(B, T, H_C, DV_C).astype(jnp.float32))
        o_c = o_c.reshape(B, T, D_C).astype(x.dtype)
        mix = jnp.concatenate([o_a, o_b, o_c], axis=-1) @ w_out[l]
        x = post_norm(x, mix, m[5], ln_g[l, 1], ln_b[l, 1])
        x = post_norm(x, 0.5 * swiglu(modulate(x, m[6], m[7]), ffn2_in[l], ffn2_out[l]), m[8], ln_g[l, 2], ln_b[l, 2])
    g_state = jnp.stack(gs_, axis=0) if sample else None
    return x, jnp.stack(ks_, axis=0), jnp.stack(vs_, axis=0), g_state, jnp.stack(ss_, axis=0)


def setup_inputs(seed: int = 0) -> dict:
    key = jax.random.key(seed)
    ks = jax.random.split(key, 26)
    f32 = jnp.float32

    def nrm(k, shape, scale):
        return jax.random.normal(k, shape, f32) * scale

    W_BUF = min(WINDOW, PAST_LEN)
    return {
        'x_prompt': nrm(ks[0], (BATCH, SEQ, D_MODEL), 1.0),
        'x_sample': nrm(ks[1], (DEC_BATCH, DEC_SEQ, D_MODEL), 1.0),
        'cache_k': nrm(ks[2], (DEPTH, DEC_BATCH, W_BUF, KV_A, HEAD_DIM), 1.0),
        'cache_v': nrm(ks[3], (DEPTH, DEC_BATCH, W_BUF, KV_A, HEAD_DIM), 1.0),
        'state_hgrn': nrm(ks[4], (DEPTH, DEC_BATCH, H_C, DK_C, DV_C), 0.5),
        'c_prompt': nrm(ks[5], (BATCH, D_MODEL), 1.0),
        'c_sample': nrm(ks[6], (DEC_BATCH, D_MODEL), 1.0),
        'w_in': nrm(ks[7], (DEPTH, D_MODEL, D_IN), D_MODEL ** -0.5),
        'w_out': nrm(ks[8], (DEPTH, D_MIX, D_MODEL), BETA * D_MIX ** -0.5),
        'attn_sinks': nrm(ks[9], (DEPTH, H_A), 0.5),
        'gmlp_ln_g': 1.0 + nrm(ks[10], (DEPTH, D_B), 0.02),
        'gmlp_ln_b': nrm(ks[11], (DEPTH, D_B), 0.02),
        'gmlp_ws': nrm(ks[12], (DEPTH, G_B, CHUNK_B, CHUNK_B), CHUNK_B ** -0.5),
        'gmlp_bs': 1.0 + nrm(ks[13], (DEPTH, G_B, CHUNK_B), 0.02),
        'hgrn_lb': nrm(ks[14], (DEPTH, H_C * DK_C), 1.0),
        'hgrn_norm_g': 1.0 + nrm(ks[15], (DEPTH, DV_C), 0.02),
        'ffn1_in': nrm(ks[16], (DEPTH, D_MODEL, 2 * D_FF), D_MODEL ** -0.5),
        'ffn1_out': nrm(ks[17], (DEPTH, D_FF, D_MODEL), BETA * D_FF ** -0.5),
        'ffn2_in': nrm(ks[18], (DEPTH, D_MODEL, 2 * D_FF), D_MODEL ** -0.5),
        'ffn2_out': nrm(ks[19], (DEPTH, D_FF, D_MODEL), BETA * D_FF ** -0.5),
        'ada_w': nrm(ks[20], (DEPTH, D_MODEL, N_MOD * D_MODEL), 0.2 * D_MODEL ** -0.5),
        'ada_b': nrm(ks[21], (DEPTH, N_MOD * D_MODEL), 0.02),
        'ln_g': 1.0 + nrm(ks[22], (DEPTH, 3, D_MODEL), 0.02),
        'ln_b': nrm(ks[23], (DEPTH, 3, D_MODEL), 0.02),
    }


def reference(x_prompt, x_sample, cache_k, cache_v, state_hgrn, c_prompt, c_sample, w_in, w_out,
              attn_sinks, gmlp_ln_g, gmlp_ln_b, gmlp_ws, gmlp_bs, hgrn_lb, hgrn_norm_g, ffn1_in,
              ffn1_out, ffn2_in, ffn2_out, ada_w, ada_b, ln_g, ln_b):
    pos_p = jnp.arange(x_prompt.shape[1])
    pos_s = PAST_LEN + jnp.arange(x_sample.shape[1])
    y_prompt, k_win_prompt, v_win_prompt, _, hgrn_state_prompt = trunk(
        x_prompt, c_prompt, pos_p, None, None, None, w_in, w_out, attn_sinks, gmlp_ln_g, gmlp_ln_b,
        gmlp_ws, gmlp_bs, hgrn_lb, hgrn_norm_g, ffn1_in, ffn1_out, ffn2_in, ffn2_out, ada_w, ada_b,
        ln_g, ln_b)
    y_sample, k_new_sample, v_new_sample, gmlp_v_sample, hgrn_state_sample = trunk(
        x_sample, c_sample, pos_s, cache_k, cache_v, state_hgrn, w_in, w_out, attn_sinks, gmlp_ln_g,
        gmlp_ln_b, gmlp_ws, gmlp_bs, hgrn_lb, hgrn_norm_g, ffn1_in, ffn1_out, ffn2_in, ffn2_out,
        ada_w, ada_b, ln_g, ln_b)
    return (y_prompt, y_sample, k_win_prompt, v_win_prompt, hgrn_state_prompt,
            k_new_sample, v_new_sample, gmlp_v_sample, hgrn_state_sample)
```

```cpp
#include <hip/hip_runtime.h>
#include <hip/hip_cooperative_groups.h>
#include <cstdio>
#include <cstdint>
namespace cg = cooperative_groups;

constexpr int DM = 1024, SEQ = 8192, MP = 16384, DECB = 128, MR = MP + DECB, MPAD = 16640;
constexpr int DIN = 2304, DFF = 2816, MODW = 9216, NCROW = 130, DEPTH = 2;
constexpr float ALPHA_F = 1.41421356237f;
__device__ __forceinline__ int crow_of(int r) { return r < MP ? (r >> 13) : (r < MR ? 2 + (r - MP) : 129); }

namespace pg8 {
#define PG8_LAS __attribute__((address_space(3)))
typedef unsigned short bf16_t;
typedef short bf16x8 __attribute__((ext_vector_type(8)));
typedef float f32x4 __attribute__((ext_vector_type(4)));
typedef unsigned u32x4 __attribute__((ext_vector_type(4)));
constexpr int BM = 256, BK = 64, HALF = 128, HTB = HALF * BK * 2  , STAGE_BYTES = 8 * HTB, NXCD = 8, WGM = 8;

__host__ __device__ __forceinline__ int lds_byte(int r, int c) { const int st = (r >> 4) * 2 + (c >> 5), rr = r & 15, cc = c & 31, ob = rr * 64 + cc * 2; return st * 1024 + (ob ^ (((ob >> 9) & 1) << 5)); }
__host__ __device__ __forceinline__ void stage_rc(int b, int& R, int& C) { const int st = b / 1024, sb = b % 1024, swz = sb ^ (((sb >> 9) & 1) << 5); R = (st >> 1) * 16 + swz / 64; C = (st & 1) * 32 + (swz % 64) / 2; }
__host__ __device__ __forceinline__ int perm32(int rho) { const int n = rho >> 4, i = rho & 15; return 8 * (i >> 2) + 4 * n + (i & 3); }

struct Unit { int pm, pn; };
struct Gemm { const bf16_t* A; const bf16_t* Bt; int M, N, K; };

struct StaticOrder {
    int nM, nN, nwg, G, c;
    __host__ __device__ void init(int M, int N, int G_, int c_) { nM = M / BM; nN = N / BM; nwg = nM * nN; G = G_; c = c_; }
    __host__ __device__ bool next(int i, Unit& u) const {
        const long L = (long)i * G + c; if (L >= nwg) return false;
        int wgid = (int)L; { const int q = nwg / NXCD, r = nwg % NXCD, xcd = wgid % NXCD, off = wgid / NXCD; wgid = (xcd < r ? xcd * (q + 1) : r * (q + 1) + (xcd - r) * q) + off; }
        const int nig = WGM * nN, gid = wgid / nig, fm = gid * WGM, gsz = (nM - fm) < WGM ? (nM - fm) : WGM;
        u.pm = fm + ((wgid % nig) % gsz); u.pn = (wgid % nig) / gsz; return true;
    }
    __device__ __forceinline__ void a_ready(const Unit&) const {}
    __device__ __forceinline__ void done(const Unit&) const {}
};

__device__ __forceinline__ unsigned cvt_pk_bf16(float lo, float hi) { unsigned r; asm volatile("v_cvt_pk_bf16_f32 %0, %1, %2" : "=v"(r) : "v"(lo), "v"(hi)); return r; }
typedef float f32x2 __attribute__((ext_vector_type(2)));

__device__ __forceinline__ float silu_f(float g) { return g * __builtin_amdgcn_rcpf(1.0f + __expf(-g)); }
struct EpiSwiglu {
    static constexpr bool PERM = true, AFTER_DRAIN = false;
    bf16_t* O;
    __device__ __forceinline__ void operator()(const f32x4 (&acc)[2][2][4][2], const Unit& u, int wr, int wc, int fr, int fq) const {
        const int row0 = u.pm * BM + wr * 64 + fr, col0 = u.pn * HALF + wc * 32 + 8 * fq;
#pragma unroll
        for (int ai = 0; ai < 2; ++ai)
#pragma unroll
            for (int m = 0; m < 4; ++m) {
                bf16_t* rowp = O + (size_t)(row0 + ai * HALF + m * 16) * DFF + col0;
                const f32x4 a0 = acc[ai][0][m][0], a1 = acc[ai][0][m][1], g0 = acc[ai][1][m][0], g1 = acc[ai][1][m][1];
                u32x4 w;
                w.x = cvt_pk_bf16(silu_f(g0[0]) * a0[0], silu_f(g0[1]) * a0[1]); w.y = cvt_pk_bf16(silu_f(g0[2]) * a0[2], silu_f(g0[3]) * a0[3]);
                w.z = cvt_pk_bf16(silu_f(g1[0]) * a1[0], silu_f(g1[1]) * a1[1]); w.w = cvt_pk_bf16(silu_f(g1[2]) * a1[2], silu_f(g1[3]) * a1[3]);
                *(u32x4*)rowp = w;
            }
    }
};
struct EpiStore {
    static constexpr bool PERM = true, AFTER_DRAIN = false;
    bf16_t* O; int ldc;
    __device__ __forceinline__ void operator()(const f32x4 (&acc)[2][2][4][2], const Unit& u, int wr, int wc, int fr, int fq) const {
        const int row0 = u.pm * BM + wr * 64 + fr, col0 = u.pn * BM + wc * 32 + 8 * fq;
#pragma unroll
        for (int ai = 0; ai < 2; ++ai)
#pragma unroll
            for (int m = 0; m < 4; ++m) {
                bf16_t* rowp = O + (size_t)(row0 + ai * HALF + m * 16) * ldc + col0;
#pragma unroll
                for (int bj = 0; bj < 2; ++bj) {
                    const f32x4 v0 = acc[ai][bj][m][0], v1 = acc[ai][bj][m][1];
                    u32x4 w; w.x = cvt_pk_bf16(v0[0], v0[1]); w.y = cvt_pk_bf16(v0[2], v0[3]); w.z = cvt_pk_bf16(v1[0], v1[1]); w.w = cvt_pk_bf16(v1[2], v1[3]);
                    *(u32x4*)(rowp + bj * HALF) = w;
                }
            }
    }
};
struct EpiResid {
    static constexpr bool PERM = false, AFTER_DRAIN = false;
    float* X; const float* gate; float scale;
    __device__ __forceinline__ void operator()(const f32x4 (&acc)[2][2][4][2], const Unit& u, int wr, int wc, int fr, int fq) const {
#pragma unroll
        for (int ai = 0; ai < 2; ++ai)
#pragma unroll
            for (int m = 0; m < 4; ++m) {
                const int r = u.pm * BM + ai * HALF + wr * 64 + m * 16 + fr;
                if (r < MR) {
                    const float* gp = gate + (size_t)crow_of(r) * MODW; float* xp = X + (size_t)r * DM;
#pragma unroll
                    for (int bj = 0; bj < 2; ++bj)
#pragma unroll
                        for (int n = 0; n < 2; ++n) {
                            const int c = u.pn * BM + bj * HALF + wc * 32 + n * 16 + 4 * fq;
                            const f32x4 gv = *(const f32x4*)(gp + c); const f32x4 xv = *(const f32x4*)(xp + c);
                            *(f32x4*)(xp + c) = xv * ALPHA_F + (gv + 1.0f) * (acc[ai][bj][m][n] * scale);
                        }
                }
            }
    }
};

struct EpiMulti {
    static constexpr bool PERM = true, AFTER_DRAIN = false;
    int mode; bf16_t* O; int ldc; float* X; const float* gate; float scale;
    __device__ __forceinline__ void operator()(const f32x4 (&acc)[2][2][4][2], const Unit& u, int wr, int wc, int fr, int fq) const {
        if (mode == 0) { EpiSwiglu e{O}; e(acc, u, wr, wc, fr, fq); }
        else if (mode == 1) { EpiStore e{O, ldc}; e(acc, u, wr, wc, fr, fq); }
        else {
#pragma unroll
            for (int ai = 0; ai < 2; ++ai)
#pragma unroll
                for (int m = 0; m < 4; ++m) {
                    const int r = u.pm * BM + ai * HALF + wr * 64 + m * 16 + fr;
                    if (r < MR) {
                        const float* gp = gate + (size_t)crow_of(r) * MODW; float* xp = X + (size_t)r * DM;
#pragma unroll
                        for (int bj = 0; bj < 2; ++bj)
#pragma unroll
                            for (int n = 0; n < 2; ++n) {
                                const int c = u.pn * BM + bj * HALF + wc * 32 + 8 * fq + 4 * n;
                                const f32x4 gv = *(const f32x4*)(gp + c); const f32x4 xv = *(const f32x4*)(xp + c);
                                *(f32x4*)(xp + c) = xv * ALPHA_F + (gv + 1.0f) * (acc[ai][bj][m][n] * scale);
                            }
                    }
                }
        }
    }
};
template <class Epi, class Sched, bool ALIGN_EPI = false, bool SP2 = false>
__device__ __forceinline__ void gemm_phase(PG8_LAS unsigned char* lds, const Gemm g, const Sched& S, const Epi& E) {
    const int tid = threadIdx.x, wid = __builtin_amdgcn_readfirstlane(tid >> 6), lane = tid & 63, wr = wid >> 2, wc = wid & 3, fr = lane & 15, fq = lane >> 4;
    const int K = g.K, nt = K / BK;
    unsigned voffA[2], voffB[2];
#pragma unroll
    for (int i = 0; i < 2; ++i) { int R, C; stage_rc(tid * 16 + i * 8192, R, C); const int Rb = Epi::PERM ? ((R & ~31) + perm32(R & 31)) : R;
        voffA[i] = (unsigned)(R * K + C) * 2u; voffB[i] = (unsigned)(Rb * K + C) * 2u; }
    const size_t kstep = (size_t)(BK * 2);
    const size_t hstep = (size_t)HALF * K * 2;
    const size_t tstep = 2 * hstep;
    const unsigned ldsw = (unsigned)wid * 1024u;
    const int aoff = lds_byte(wr * 64 + fr, fq * 8), boff = lds_byte(wc * 32 + fr, fq * 8);
#define PG8_SA(b, h) (((b) * 2 + (h)) * HTB)
#define PG8_SB(b, h) ((4 + (b) * 2 + (h)) * HTB)
#define PG8_STAGE(bufoff, gbase, voff) do { _Pragma("unroll") for (int _i = 0; _i < 2; ++_i) \
        __builtin_amdgcn_global_load_lds((const unsigned*)((const char*)(gbase) + (voff)[_i]), (PG8_LAS unsigned*)(lds + (bufoff) + ldsw + _i * 8192), 16, 0, 0); } while (0)
#define PG8_LDA(dst, b, h) do { _Pragma("unroll") for (int m = 0; m < 4; ++m) _Pragma("unroll") for (int k = 0; k < 2; ++k) dst[m][k] = *(const PG8_LAS bf16x8*)(lds + PG8_SA(b, h) + aoff + m * 2048 + k * 1024); } while (0)
#define PG8_LDB(dst, b, h) do { _Pragma("unroll") for (int n = 0; n < 2; ++n) _Pragma("unroll") for (int k = 0; k < 2; ++k) dst[n][k] = *(const PG8_LAS bf16x8*)(lds + PG8_SB(b, h) + boff + n * 2048 + k * 1024); } while (0)
#define PG8_MMA(ai, bj, At, Bt) do { __builtin_amdgcn_s_setprio(1); _Pragma("unroll") for (int m = 0; m < 4; ++m) _Pragma("unroll") for (int n = 0; n < 2; ++n) _Pragma("unroll") for (int k = 0; k < 2; ++k) \
        acc[ai][bj][m][n] = __builtin_amdgcn_mfma_f32_16x16x32_bf16(Bt[n][k], At[m][k], acc[ai][bj][m][n], 0, 0, 0); __builtin_amdgcn_s_setprio(0); } while (0)
#define PG8_WAIT_V(n) asm volatile("s_waitcnt vmcnt(" #n ")" ::: "memory")
#define PG8_WAIT_L(n) asm volatile("s_waitcnt lgkmcnt(" #n ")" ::: "memory")
#define PG8_BAR __builtin_amdgcn_s_barrier()
#define PG8_SCHED __builtin_amdgcn_sched_barrier(0)
    Unit cur, nxt; int ui = 0;
    if (!S.next(0, cur)) return;
    f32x4 acc[2][2][4][2];
#pragma unroll
    for (int a = 0; a < 2; ++a)
#pragma unroll
        for (int b = 0; b < 2; ++b)
#pragma unroll
            for (int m = 0; m < 4; ++m)
#pragma unroll
                for (int n = 0; n < 2; ++n) acc[a][b][m][n] = (f32x4){0.f, 0.f, 0.f, 0.f};
    bf16x8 At[4][2], B0[2][2], B1[2][2];
    const char* cA = (const char*)g.A + (size_t)cur.pm * tstep; const char* cB = (const char*)g.Bt + (size_t)cur.pn * tstep;
    S.a_ready(cur);
    if constexpr (SP2) {
        PG8_STAGE(PG8_SB(0, 0), cB, voffB); PG8_STAGE(PG8_SB(0, 1), cB + hstep, voffB); PG8_STAGE(PG8_SA(0, 0), cA, voffA); PG8_STAGE(PG8_SA(0, 1), cA + hstep, voffA);
        if (wr == 1) PG8_BAR;
        PG8_WAIT_V(2); PG8_BAR;
        PG8_STAGE(PG8_SB(1, 0), cB + kstep, voffB); PG8_STAGE(PG8_SA(1, 0), cA + kstep, voffA); PG8_STAGE(PG8_SB(1, 1), cB + hstep + kstep, voffB);
        PG8_WAIT_V(6); PG8_BAR;
    } else {
        PG8_STAGE(PG8_SB(0, 0), cB, voffB); PG8_STAGE(PG8_SA(0, 0), cA, voffA); PG8_STAGE(PG8_SB(0, 1), cB + hstep, voffB); PG8_STAGE(PG8_SA(0, 1), cA + hstep, voffA);
        if (wr == 1) PG8_BAR;
        PG8_WAIT_V(4); PG8_BAR;
        PG8_STAGE(PG8_SB(1, 0), cB + kstep, voffB); PG8_STAGE(PG8_SA(1, 0), cA + kstep, voffA); PG8_STAGE(PG8_SB(1, 1), cB + hstep + kstep, voffB);
        PG8_WAIT_V(6); PG8_BAR;
    }
    for (;;) {
        const bool has_next = S.next(ui + 1, nxt);
        const char* nA = has_next ? (const char*)g.A + (size_t)nxt.pm * tstep : cA; const char* nB = has_next ? (const char*)g.Bt + (size_t)nxt.pn * tstep : cB;
        for (int t = 0; t < nt; t += 2) {
            const bool last = (t == nt - 2);
            const char* a1 = cA + (size_t)(t + 1) * kstep;
            const char* a2 = last ? nA : cA + (size_t)(t + 2) * kstep; const char* b2 = last ? nB : cB + (size_t)(t + 2) * kstep;
            const char* a3 = a2 + kstep; const char* b3 = b2 + kstep;
            if (last && has_next) S.a_ready(nxt);
            if constexpr (SP2) {
            PG8_LDB(B0, 0, 0); PG8_LDB(B1, 0, 1); PG8_SCHED; PG8_LDA(At, 0, 0); PG8_STAGE(PG8_SA(1, 1), a1 + hstep, voffA);
            PG8_WAIT_V(8); PG8_WAIT_L(0); PG8_BAR; PG8_MMA(0, 0, At, B0); PG8_MMA(0, 1, At, B1); PG8_BAR; PG8_SCHED;
            PG8_LDA(At, 0, 1); PG8_STAGE(PG8_SB(0, 0), b2, voffB); PG8_STAGE(PG8_SB(0, 1), b2 + hstep, voffB); PG8_STAGE(PG8_SA(0, 0), a2, voffA);
            PG8_WAIT_V(8); PG8_WAIT_L(0); PG8_BAR; PG8_MMA(1, 0, At, B0); PG8_MMA(1, 1, At, B1); PG8_BAR; PG8_SCHED;
            PG8_LDB(B0, 1, 0); PG8_LDB(B1, 1, 1); PG8_SCHED; PG8_LDA(At, 1, 0); PG8_STAGE(PG8_SA(0, 1), a2 + hstep, voffA);
            PG8_WAIT_V(8); PG8_WAIT_L(0); PG8_BAR; PG8_MMA(0, 0, At, B0); PG8_MMA(0, 1, At, B1); PG8_BAR; PG8_SCHED;
            PG8_LDA(At, 1, 1); PG8_STAGE(PG8_SB(1, 0), b3, voffB); PG8_STAGE(PG8_SB(1, 1), b3 + hstep, voffB); PG8_STAGE(PG8_SA(1, 0), a3, voffA);
            PG8_WAIT_V(8); PG8_WAIT_L(0); PG8_BAR; PG8_MMA(1, 0, At, B0); PG8_MMA(1, 1, At, B1); PG8_BAR; PG8_SCHED;
            } else {
            PG8_LDB(B0, 0, 0); PG8_SCHED; PG8_LDA(At, 0, 0); PG8_STAGE(PG8_SA(1, 1), a1 + hstep, voffA);
            PG8_WAIT_L(8); PG8_BAR; PG8_WAIT_L(0); PG8_MMA(0, 0, At, B0); PG8_BAR; PG8_SCHED;
            PG8_LDB(B1, 0, 1); PG8_STAGE(PG8_SB(0, 0), b2, voffB);
            PG8_BAR; PG8_WAIT_L(0); PG8_MMA(0, 1, At, B1); PG8_BAR;
            PG8_LDA(At, 0, 1); PG8_STAGE(PG8_SA(0, 0), a2, voffA);
            PG8_BAR; PG8_WAIT_L(0); PG8_MMA(1, 0, At, B0); PG8_BAR; PG8_SCHED;
            PG8_STAGE(PG8_SB(0, 1), b2 + hstep, voffB);
            PG8_WAIT_V(6); PG8_BAR; PG8_MMA(1, 1, At, B1); PG8_BAR;
            PG8_LDB(B0, 1, 0); PG8_SCHED; PG8_LDA(At, 1, 0); PG8_STAGE(PG8_SA(0, 1), a2 + hstep, voffA);
            PG8_WAIT_L(8); PG8_BAR; PG8_WAIT_L(0); PG8_MMA(0, 0, At, B0); PG8_BAR; PG8_SCHED;
            PG8_LDB(B1, 1, 1); PG8_STAGE(PG8_SB(1, 0), b3, voffB);
            PG8_BAR; PG8_WAIT_L(0); PG8_MMA(0, 1, At, B1); PG8_BAR;
            PG8_LDA(At, 1, 1); PG8_STAGE(PG8_SA(1, 0), a3, voffA);
            PG8_BAR; PG8_WAIT_L(0); PG8_MMA(1, 0, At, B0); PG8_BAR; PG8_SCHED;
            PG8_STAGE(PG8_SB(1, 1), b3 + hstep, voffB);
            PG8_WAIT_V(6); PG8_BAR; PG8_MMA(1, 1, At, B1); PG8_BAR;
            }
        }
        if constexpr (ALIGN_EPI) { if (wr == 0) PG8_BAR; }
        if constexpr (!Epi::AFTER_DRAIN) { E(acc, cur, wr, wc, fr, fq); S.done(cur); }
        if (!has_next) break;
#pragma unroll
        for (int a = 0; a < 2; ++a)
#pragma unroll
            for (int b = 0; b < 2; ++b)
#pragma unroll
                for (int m = 0; m < 4; ++m)
#pragma unroll
                    for (int n = 0; n < 2; ++n) acc[a][b][m][n] = (f32x4){0.f, 0.f, 0.f, 0.f};
        cur = nxt; cA = nA; cB = nB; ++ui;
        if constexpr (ALIGN_EPI) { if (wr == 1) PG8_BAR; }
    }
    PG8_WAIT_V(0);
    if constexpr (!ALIGN_EPI) { if (wr == 0) PG8_BAR; }
    PG8_BAR;
    if constexpr (Epi::AFTER_DRAIN) { E.fused(acc, cur, wr, wc, fr, fq, lds, wid, lane); S.done(cur); }
#undef PG8_SA
#undef PG8_SB
#undef PG8_STAGE
#undef PG8_LDA
#undef PG8_LDB
#undef PG8_MMA
#undef PG8_WAIT_V
#undef PG8_WAIT_L
#undef PG8_BAR
#undef PG8_SCHED
}
}

constexpr size_t MiB = 1u << 20;
constexpr size_t WS_FFIN = 1 * MiB;
constexpr size_t WS_FFOUT = 45 * MiB;
constexpr size_t WS_WIN = 67 * MiB;
constexpr size_t WS_WOUT = 76 * MiB;
constexpr size_t WS_MOD = 80 * MiB;
constexpr size_t WS_ROPE = 90 * MiB;
constexpr size_t WS_H = 91 * MiB;
constexpr size_t WS_ACT = 124 * MiB;
constexpr size_t WS_PROJ = 124 * MiB;
constexpr size_t WS_MIX = 198 * MiB;
constexpr size_t WS_HGS = 231 * MiB;
constexpr size_t WS_HGD = 235 * MiB;
constexpr size_t WS_END = 236 * MiB;
constexpr size_t O_Y = 0, O_KWIN = 16908288, O_VWIN = 16973824, O_HSP = 17039360, O_KNEW = 17104896, O_VNEW = 17137664, O_GV = 17170432, O_HSS = 17235968;

constexpr int LDS_BYTES = 147456;
constexpr int NPH = 26;

#define LAS __attribute__((address_space(3)))
typedef unsigned short bf16_t;
typedef short bf16x8 __attribute__((ext_vector_type(8)));
typedef float f32x4 __attribute__((ext_vector_type(4)));
typedef unsigned u32x4 __attribute__((ext_vector_type(4)));
typedef unsigned u32x2 __attribute__((ext_vector_type(2)));

__device__ __forceinline__ float bf2f(unsigned h) { return __uint_as_float(h << 16); }
__device__ __forceinline__ unsigned f2bf(float f) { unsigned u = __float_as_uint(f); return (u + 0x7fffu + ((u >> 16) & 1u)) >> 16; }
__device__ __forceinline__ unsigned pk2(float lo, float hi) { return f2bf(lo) | (f2bf(hi) << 16); }
__device__ __forceinline__ void unpack8(const u32x4 w, float* x) {
    x[0] = __uint_as_float(w.x << 16); x[1] = __uint_as_float(w.x & 0xffff0000u); x[2] = __uint_as_float(w.y << 16); x[3] = __uint_as_float(w.y & 0xffff0000u);
    x[4] = __uint_as_float(w.z << 16); x[5] = __uint_as_float(w.z & 0xffff0000u); x[6] = __uint_as_float(w.w << 16); x[7] = __uint_as_float(w.w & 0xffff0000u);
}
__device__ __forceinline__ u32x4 pack8(const float* x) { u32x4 w; w.x = pk2(x[0], x[1]); w.y = pk2(x[2], x[3]); w.z = pk2(x[4], x[5]); w.w = pk2(x[6], x[7]); return w; }
__device__ __forceinline__ float sigmoid_f(float x) { return 1.0f / (1.0f + __expf(-x)); }
__device__ __forceinline__ float silu2(float x) { return x / (1.0f + __expf(-x)); }
__device__ __forceinline__ float wave_sum(float v) {
#pragma unroll
    for (int o = 1; o < 64; o <<= 1) v += __shfl_xor(v, o);
    return v;
}
__device__ __forceinline__ float wave_max(float v) {
#pragma unroll
    for (int o = 1; o < 64; o <<= 1) v = fmaxf(v, __shfl_xor(v, o));
    return v;
}

struct Args { const float* in[24]; float* out; unsigned char* ws; int ph_lo, ph_hi; };

struct Ctx {
    LAS unsigned char* lds;
    int tid, lane, wave, G, bid;
    const float* const* in;
    float* out; unsigned char* ws;
};
#define IN(i) (C.in[i])
#define WSP(T, off) ((T*)(C.ws + (off)))

__device__ __forceinline__ void transpose_item(const float* W, int K, int N, bf16_t* WT, int k0, int n0, int drow, LAS float* scr, int lane) {
#pragma unroll 8
    for (int i = 0; i < 32; ++i) { const int kk = 2 * i + (lane >> 5); scr[kk * 33 + (lane & 31)] = W[(size_t)(k0 + kk) * N + n0 + (lane & 31)]; }
    asm volatile("s_waitcnt lgkmcnt(0)" ::: "memory");
    const int c = lane & 7;
#pragma unroll
    for (int j = 0; j < 4; ++j) { const int n = (lane >> 3) + 8 * j; const LAS float* s = scr + (8 * c) * 33 + n;
        u32x4 o; o.x = pk2(s[0 * 33], s[1 * 33]); o.y = pk2(s[2 * 33], s[3 * 33]); o.z = pk2(s[4 * 33], s[5 * 33]); o.w = pk2(s[6 * 33], s[7 * 33]);
        *(u32x4*)(WT + (size_t)(drow + n) * K + k0 + 8 * c) = o; }
    asm volatile("s_waitcnt lgkmcnt(0)" ::: "memory");
}
__device__ __forceinline__ void phase_prologue(const Ctx& C) {
    {
        LAS float* scr = (LAS float*)(C.lds + C.wave * 8448);
        const int gw = C.bid * 8 + C.wave, NGW = C.G * 8;
        constexpr int I_FI = 16 * 176, I_FO = 44 * 32, I_WI = 16 * 72, I_WO = 16 * 32;
        constexpr int NIT = 4 * I_FI + 4 * I_FO + 2 * I_WI + 2 * I_WO;
        for (int it = gw; it < NIT; it += NGW) {
            int r = it;
            if (r < 4 * I_FI) { const int mi = r / I_FI, q = r % I_FI, l = mi >> 1, f = mi & 1; const int kb = q / 176, nb = q % 176, n0 = nb * 32;
                const int half = n0 >= DFF ? 1 : 0, j0 = n0 - half * DFF, drow = 256 * (j0 >> 7) + 128 * half + (j0 & 127);
                transpose_item(IN(f ? 18 : 16) + (size_t)l * DM * 2 * DFF, DM, 2 * DFF, WSP(bf16_t, WS_FFIN) + (size_t)mi * 2 * DFF * DM, kb * 64, n0, drow, scr, C.lane); continue; }
            r -= 4 * I_FI;
            if (r < 4 * I_FO) { const int mi = r / I_FO, q = r % I_FO, l = mi >> 1, f = mi & 1; const int kb = q / 32, nb = q % 32;
                transpose_item(IN(f ? 19 : 17) + (size_t)l * DFF * DM, DFF, DM, WSP(bf16_t, WS_FFOUT) + (size_t)mi * DM * DFF, kb * 64, nb * 32, nb * 32, scr, C.lane); continue; }
            r -= 4 * I_FO;
            if (r < 2 * I_WI) { const int l = r / I_WI, q = r % I_WI; const int kb = q / 72, nb = q % 72;
                transpose_item(IN(7) + (size_t)l * DM * DIN, DM, DIN, WSP(bf16_t, WS_WIN) + (size_t)l * DIN * DM, kb * 64, nb * 32, nb * 32, scr, C.lane); continue; }
            r -= 2 * I_WI;
            { const int l = r / I_WO, q = r % I_WO; const int kb = q / 32, nb = q % 32;
                transpose_item(IN(8) + (size_t)l * DM * DM, DM, DM, WSP(bf16_t, WS_WOUT) + (size_t)l * DM * DM, kb * 64, nb * 32, nb * 32, scr, C.lane); }
        }
    }
    {
        float* rt = WSP(float, WS_ROPE);
        for (int e = C.bid * 512 + C.tid; e < 8193 * 8; e += C.G * 512) {
            const int p = e >> 3, i = e & 7; const int pos = (p == 8192) ? 16384 : p;
            const float invf = exp2f(-(float)i * 2.3664460711655217f);
            const double rev = (double)pos * (double)invf * 0.15915494309189535;
            const float r = (float)((rev - rint(rev)) * 6.283185307179586);
            rt[p * 16 + i] = __cosf(r); rt[p * 16 + 8 + i] = __sinf(r);
        }
    }
    __syncthreads();
    {
        LAS float* cs = (LAS float*)C.lds;
        const int col = C.tid & 63, rg = C.tid >> 6;
        for (int item = C.bid; item < 2 * 144; item += C.G) {
            const int l = item / 144, cb = item % 144, n = cb * 64 + col;
            const float* W = IN(20) + (size_t)l * DM * MODW + n;
            float acc[17];
#pragma unroll
            for (int i = 0; i < 17; ++i) acc[i] = 0.f;
            for (int kc = 0; kc < DM; kc += 128) {
                __syncthreads();
                for (int e = C.tid; e < 136 * 128; e += 512) { const int r = e >> 7, k = e & 127; float v = 0.f;
                    if (r < NCROW) { const float cv = r < 2 ? IN(5)[r * DM + kc + k] : IN(6)[(r - 2) * DM + kc + k]; v = silu2(cv); }
                    cs[e] = v; }
                __syncthreads();
#pragma unroll 2
                for (int k = 0; k < 128; k += 4) {
                    const float w0 = W[(size_t)(kc + k) * MODW], w1 = W[(size_t)(kc + k + 1) * MODW], w2 = W[(size_t)(kc + k + 2) * MODW], w3 = W[(size_t)(kc + k + 3) * MODW];
#pragma unroll
                    for (int i = 0; i < 17; ++i) { const f32x4 s = *(const LAS f32x4*)(cs + (rg + 8 * i) * 128 + k); acc[i] += s.x * w0 + s.y * w1 + s.z * w2 + s.w * w3; }
                }
            }
            const float bias = IN(21)[l * MODW + n];
            float* mo = WSP(float, WS_MOD) + (size_t)l * NCROW * MODW + n;
#pragma unroll
            for (int i = 0; i < 17; ++i) { const int r = rg + 8 * i; if (r < NCROW) mo[(size_t)r * MODW] = acc[i] + bias; }
        }
    }
}

__device__ __forceinline__ void phase_mod0(const Ctx& C) {
    const int gw = C.bid * 8 + C.wave, NGW = C.G * 8;
    const float* mod = WSP(float, WS_MOD);
    for (int r = gw; r < MR; r += NGW) {
        const float* xs = r < MP ? IN(0) + (size_t)r * DM : IN(1) + (size_t)(r - MP) * DM;
        const float* mp = mod + (size_t)crow_of(r) * MODW;
        float* xo = C.out + (size_t)r * DM; bf16_t* ho = WSP(bf16_t, WS_H) + (size_t)r * DM;
#pragma unroll
        for (int j = 0; j < 4; ++j) { const int c = 4 * C.lane + 256 * j;
            const f32x4 x = *(const f32x4*)(xs + c), sh = *(const f32x4*)(mp + c), sc = *(const f32x4*)(mp + DM + c);
            *(f32x4*)(xo + c) = x; const f32x4 h = x * (sc + 1.0f) + sh;
            u32x2 w; w.x = pk2(h.x, h.y); w.y = pk2(h.z, h.w); *(u32x2*)(ho + c) = w; }
    }
}

__device__ __forceinline__ void phase_ln(const Ctx& C, int l, int which) {
    const int gw = C.bid * 8 + C.wave, NGW = C.G * 8;
    const float* g = IN(22) + (size_t)(l * 3 + which) * DM; const float* bb = IN(23) + (size_t)(l * 3 + which) * DM;
    int ml = l, si = (which == 0) ? 3 : 6; bool has = true;
    if (which == 2) { ml = l + 1; si = 0; has = (ml < DEPTH); }
    const float* mod = WSP(float, WS_MOD) + (size_t)(has ? ml : 0) * NCROW * MODW + (size_t)si * DM;
    for (int r = gw; r < MR; r += NGW) {
        float* xp = C.out + (size_t)r * DM; bf16_t* ho = WSP(bf16_t, WS_H) + (size_t)r * DM;
        f32x4 v[4]; float s = 0.f;
#pragma unroll
        for (int j = 0; j < 4; ++j) { v[j] = *(const f32x4*)(xp + 4 * C.lane + 256 * j); s += (v[j].x + v[j].y) + (v[j].z + v[j].w); }
        const float mean = wave_sum(s) * (1.0f / DM); float s2 = 0.f;
#pragma unroll
        for (int j = 0; j < 4; ++j) { v[j] = v[j] - mean; s2 += (v[j].x * v[j].x + v[j].y * v[j].y) + (v[j].z * v[j].z + v[j].w * v[j].w); }
        const float rstd = 1.0f / sqrtf(wave_sum(s2) * (1.0f / DM) + 1e-5f);
        const float* mp = mod + (size_t)crow_of(r) * MODW;
#pragma unroll
        for (int j = 0; j < 4; ++j) { const int c = 4 * C.lane + 256 * j;
            const f32x4 y = v[j] * rstd * *(const f32x4*)(g + c) + *(const f32x4*)(bb + c);
            *(f32x4*)(xp + c) = y;
            if (has) { const f32x4 sh = *(const f32x4*)(mp + c), sc = *(const f32x4*)(mp + DM + c); const f32x4 h = y * (sc + 1.0f) + sh;
                u32x2 w; w.x = pk2(h.x, h.y); w.y = pk2(h.z, h.w); *(u32x2*)(ho + c) = w; }
        }
    }
}

__device__ __forceinline__ int vperm(int key) { return (key & ~31) | (((key >> 2) & 3) << 3) | (((key >> 4) & 1) << 2) | (key & 3); }
__device__ __forceinline__ void attn_prompt_item(const Ctx& C, int l, int item) {
    const int b = item >> 7, blk = (item >> 1) & 63, kvh = item & 1;
    LAS bf16_t* Ks = (LAS bf16_t*)C.lds;
    LAS bf16_t* Vt = (LAS bf16_t*)(C.lds + 36864);
    const bf16_t* P = WSP(bf16_t, WS_PROJ) + (size_t)b * SEQ * DIN;
    const float* rope = WSP(float, WS_ROPE);
    __syncthreads();
    for (int idx = C.tid; idx < 2048; idx += 512) {
        const int key = idx >> 3, seg = idx & 7; const int t = (blk - 1) * 128 + key;
        u32x4 kw = (u32x4){0u, 0u, 0u, 0u}, vw = (u32x4){0u, 0u, 0u, 0u};
        float kf[8], vf[8];
        if (t >= 0) {
            const bf16_t* rp = P + (size_t)t * DIN;
            kw = *(const u32x4*)(rp + 512 + kvh * 64 + seg * 8); vw = *(const u32x4*)(rp + 640 + kvh * 64 + seg * 8);
            if (seg < 2) {
                const u32x4 ow = *(const u32x4*)(rp + 512 + kvh * 64 + (seg ^ 1) * 8);
                float of[8]; unpack8(kw, kf); unpack8(ow, of);
                const float* rr = rope + (size_t)t * 16;
#pragma unroll
                for (int e = 0; e < 8; ++e) { const float cs = rr[e], sn = rr[8 + e]; kf[e] = (seg == 0) ? (kf[e] * cs - of[e] * sn) : (kf[e] * cs + of[e] * sn); }
                kw = pack8(kf);
            }
        }
        *(LAS u32x4*)(Ks + key * 72 + seg * 8) = kw;
        unpack8(vw, vf);
        const int pk = vperm(key);
#pragma unroll
        for (int e = 0; e < 8; ++e) Vt[(seg * 8 + e) * 264 + pk] = (bf16_t)(__float_as_uint(vf[e]) >> 16);
        if (blk == 63 && key >= 128) {
            unpack8(kw, kf);
            const size_t o = ((size_t)((l * 2 + b) * 128 + (key - 128)) * 2 + kvh) * 64 + seg * 8;
            *(f32x4*)(C.out + O_KWIN + o) = (f32x4){kf[0], kf[1], kf[2], kf[3]}; *(f32x4*)(C.out + O_KWIN + o + 4) = (f32x4){kf[4], kf[5], kf[6], kf[7]};
            *(f32x4*)(C.out + O_VWIN + o) = (f32x4){vf[0], vf[1], vf[2], vf[3]}; *(f32x4*)(C.out + O_VWIN + o + 4) = (f32x4){vf[4], vf[5], vf[6], vf[7]};
        }
    }
    __syncthreads();
    const int w = C.wave, lane = C.lane, fr = lane & 15, fq = lane >> 4;
    const int hq = kvh * 4 + (w >> 1);
    const float sink = IN(9)[l * 8 + hq];
    bf16_t* MIX = WSP(bf16_t, WS_MIX) + (size_t)b * SEQ * DM;
#pragma unroll 1
    for (int st = 0; st < 4; ++st) {
        const int isub = (w & 1) * 4 + st; const int t = blk * 128 + isub * 16 + fr;
        const bf16_t* qp = P + (size_t)t * DIN + hq * 64;
        u32x4 q0w = *(const u32x4*)(qp + fq * 8); const u32x4 q1w = *(const u32x4*)(qp + 32 + fq * 8);
        {
            float x[8], o[8]; unpack8(q0w, x);
#pragma unroll
            for (int e = 0; e < 8; ++e) o[e] = __shfl_xor(x[e], 16);
            const float* rr = rope + (size_t)t * 16;
            if (fq < 2) {
#pragma unroll
                for (int e = 0; e < 8; ++e) { const float cs = rr[e], sn = rr[8 + e]; x[e] = (fq == 0) ? (x[e] * cs - o[e] * sn) : (x[e] * cs + o[e] * sn); }
                q0w = pack8(x);
            }
        }
        const bf16x8 q0 = __builtin_bit_cast(bf16x8, q0w), q1 = __builtin_bit_cast(bf16x8, q1w);
        const int kbase = 32 * (isub >> 1);
        f32x4 s[10];
#pragma unroll
        for (int j = 0; j < 10; ++j) {
            const LAS bf16_t* kp = Ks + (kbase + 16 * j + fr) * 72 + fq * 8;
            const bf16x8 a0 = *(const LAS bf16x8*)kp, a1 = *(const LAS bf16x8*)(kp + 32);
            f32x4 z = (f32x4){0.f, 0.f, 0.f, 0.f};
            z = __builtin_amdgcn_mfma_f32_16x16x32_bf16(a0, q0, z, 0, 0, 0);
            s[j] = __builtin_amdgcn_mfma_f32_16x16x32_bf16(a1, q1, z, 0, 0, 0);
        }
        const int qi = 128 + isub * 16 + fr;
        float mx = sink;
#pragma unroll
        for (int j = 0; j < 10; ++j)
#pragma unroll
            for (int i = 0; i < 4; ++i) { const int kj = kbase + 16 * j + 4 * fq + i;
                const bool valid = (kj <= qi) && (qi - kj < 128) && (blk > 0 || kj >= 128);
                const float v = valid ? s[j][i] * 0.125f : -1e30f; s[j][i] = v; mx = fmaxf(mx, v); }
        mx = fmaxf(mx, __shfl_xor(mx, 16)); mx = fmaxf(mx, __shfl_xor(mx, 32));
        float sum = 0.f;
#pragma unroll
        for (int j = 0; j < 10; ++j)
#pragma unroll
            for (int i = 0; i < 4; ++i) { const float p = __expf(s[j][i] - mx); s[j][i] = p; sum += p; }
        sum += __shfl_xor(sum, 16); sum += __shfl_xor(sum, 32); sum += __expf(sink - mx);
        const float rl = 1.0f / sum;
        f32x4 o[4];
#pragma unroll
        for (int dt = 0; dt < 4; ++dt) o[dt] = (f32x4){0.f, 0.f, 0.f, 0.f};
#pragma unroll
        for (int g = 0; g < 5; ++g) {
            u32x4 pw; pw.x = pk2(s[2 * g][0], s[2 * g][1]); pw.y = pk2(s[2 * g][2], s[2 * g][3]); pw.z = pk2(s[2 * g + 1][0], s[2 * g + 1][1]); pw.w = pk2(s[2 * g + 1][2], s[2 * g + 1][3]);
            const bf16x8 pb = __builtin_bit_cast(bf16x8, pw);
#pragma unroll
            for (int dt = 0; dt < 4; ++dt) {
                const bf16x8 av = *(const LAS bf16x8*)(Vt + (dt * 16 + fr) * 264 + kbase + 32 * g + fq * 8);
                o[dt] = __builtin_amdgcn_mfma_f32_16x16x32_bf16(av, pb, o[dt], 0, 0, 0);
            }
        }
        bf16_t* op = MIX + (size_t)t * DM + hq * 64 + 4 * fq;
#pragma unroll
        for (int dt = 0; dt < 4; ++dt) { u32x2 wv; wv.x = pk2(o[dt][0] * rl, o[dt][1] * rl); wv.y = pk2(o[dt][2] * rl, o[dt][3] * rl); *(u32x2*)(op + dt * 16) = wv; }
    }
}

__device__ __forceinline__ float hgrn_lb(const Ctx& C, int l, int j) { return l == 0 ? 0.f : sigmoid_f(IN(14)[256 + j] - IN(14)[j]); }
template <int PASS> __device__ __forceinline__ void hgrn_item(const Ctx& C, int l, int item) {
    const int chain = item >> 5, chunk = item & 31, b = chain >> 2, h = chain & 3, t0 = chunk * 256;
    LAS float* Fs = (LAS float*)C.lds; LAS float* Kk = Fs + 4096; LAS float* Is = Fs + 8192; LAS float* Qs = Fs + 12288; LAS float* Ob = Fs + 16384;
    const int w = C.wave, lane = C.lane, kg = lane >> 3, v8 = lane & 7, v = 8 * w + v8;
    float* HS = WSP(float, WS_HGS) + (size_t)(chain * 32 + chunk) * 4096;
    float S[8], Dp[8];
#pragma unroll
    for (int j = 0; j < 8; ++j) { S[j] = (PASS == 2 && chunk > 0) ? HS[(kg * 8 + j) * 64 + v] : 0.f; Dp[j] = 1.f; }
    const int tt = C.tid >> 3, seg = C.tid & 7;
    float lbv[8];
#pragma unroll
    for (int e = 0; e < 8; ++e) lbv[e] = hgrn_lb(C, l, h * 64 + seg * 8 + e);
    const bf16_t* P = WSP(bf16_t, WS_PROJ) + (size_t)(b * SEQ + t0) * DIN;
#pragma unroll 1
    for (int sub = 0; sub < 4; ++sub) {
        __syncthreads();
        const bf16_t* rp = P + (size_t)(sub * 64 + tt) * DIN;
        {
            float cf[8], ci[8];
            unpack8(*(const u32x4*)(rp + 1536 + h * 64 + seg * 8), cf); unpack8(*(const u32x4*)(rp + 1792 + h * 64 + seg * 8), ci);
            float f[8], kk[8];
#pragma unroll
            for (int e = 0; e < 8; ++e) { f[e] = lbv[e] + (1.0f - lbv[e]) * sigmoid_f(cf[e]); kk[e] = 1.0f - f[e]; }
            LAS float* d = Fs + tt * 64 + seg * 8;
            *(LAS f32x4*)d = (f32x4){f[0], f[1], f[2], f[3]}; *(LAS f32x4*)(d + 4) = (f32x4){f[4], f[5], f[6], f[7]};
            *(LAS f32x4*)(d + 4096) = (f32x4){kk[0], kk[1], kk[2], kk[3]}; *(LAS f32x4*)(d + 4100) = (f32x4){kk[4], kk[5], kk[6], kk[7]};
            *(LAS f32x4*)(d + 8192) = (f32x4){ci[0], ci[1], ci[2], ci[3]}; *(LAS f32x4*)(d + 8196) = (f32x4){ci[4], ci[5], ci[6], ci[7]};
            if (PASS == 2) { float cq[8]; unpack8(*(const u32x4*)(rp + 1280 + h * 64 + seg * 8), cq);
                *(LAS f32x4*)(d + 12288) = (f32x4){cq[0], cq[1], cq[2], cq[3]}; *(LAS f32x4*)(d + 12292) = (f32x4){cq[4], cq[5], cq[6], cq[7]}; }
        }
        __syncthreads();
#pragma unroll 4
        for (int t = 0; t < 64; ++t) {
            const f32x4 fa = *(const LAS f32x4*)(Fs + t * 64 + kg * 8), fb = *(const LAS f32x4*)(Fs + t * 64 + kg * 8 + 4);
            const f32x4 ka = *(const LAS f32x4*)(Kk + t * 64 + kg * 8), kb = *(const LAS f32x4*)(Kk + t * 64 + kg * 8 + 4);
            const float iv = Is[t * 64 + v];
            S[0] = fa.x * S[0] + ka.x * iv; S[1] = fa.y * S[1] + ka.y * iv; S[2] = fa.z * S[2] + ka.z * iv; S[3] = fa.w * S[3] + ka.w * iv;
            S[4] = fb.x * S[4] + kb.x * iv; S[5] = fb.y * S[5] + kb.y * iv; S[6] = fb.z * S[6] + kb.z * iv; S[7] = fb.w * S[7] + kb.w * iv;
            if (PASS == 1) { Dp[0] *= fa.x; Dp[1] *= fa.y; Dp[2] *= fa.z; Dp[3] *= fa.w; Dp[4] *= fb.x; Dp[5] *= fb.y; Dp[6] *= fb.z; Dp[7] *= fb.w; }
            else {
                const f32x4 qa = *(const LAS f32x4*)(Qs + t * 64 + kg * 8), qb = *(const LAS f32x4*)(Qs + t * 64 + kg * 8 + 4);
                float o = qa.x * S[0] + qa.y * S[1] + qa.z * S[2] + qa.w * S[3] + qb.x * S[4] + qb.y * S[5] + qb.z * S[6] + qb.w * S[7];
                o += __shfl_xor(o, 8); o += __shfl_xor(o, 16); o += __shfl_xor(o, 32);
                if (kg == 0) Ob[t * 64 + v] = o;
            }
        }
        if (PASS == 2) {
            __syncthreads();
            const f32x4 oa = *(const LAS f32x4*)(Ob + tt * 64 + seg * 8), ob = *(const LAS f32x4*)(Ob + tt * 64 + seg * 8 + 4);
            float ss = oa.x * oa.x + oa.y * oa.y + oa.z * oa.z + oa.w * oa.w + ob.x * ob.x + ob.y * ob.y + ob.z * ob.z + ob.w * ob.w;
            ss += __shfl_xor(ss, 1); ss += __shfl_xor(ss, 2); ss += __shfl_xor(ss, 4);
            const float r = 1.0f / sqrtf(ss * (1.0f / 64.0f) + 1e-6f);
            float cg[8]; unpack8(*(const u32x4*)(rp + 2048 + h * 64 + seg * 8), cg);
            const float* gn = IN(15) + l * 64 + seg * 8;
            float y[8]; const float ov[8] = {oa.x, oa.y, oa.z, oa.w, ob.x, ob.y, ob.z, ob.w};
#pragma unroll
            for (int e = 0; e < 8; ++e) y[e] = ov[e] * r * gn[e] * silu2(cg[e]);
            *(u32x4*)(WSP(bf16_t, WS_MIX) + (size_t)(b * SEQ + t0 + sub * 64 + tt) * DM + 768 + h * 64 + seg * 8) = pack8(y);
        }
    }
    if (PASS == 1) {
#pragma unroll
        for (int j = 0; j < 8; ++j) HS[(kg * 8 + j) * 64 + v] = S[j];
        if (w == 0 && v8 == 0) {
            float* HD = WSP(float, WS_HGD) + (size_t)(chain * 32 + chunk) * 64 + kg * 8;
#pragma unroll
            for (int j = 0; j < 8; ++j) HD[j] = Dp[j];
        }
    }
}
__device__ __forceinline__ void hgrn_scan(const Ctx& C, int l) {
    if (C.tid < 128) {
        for (int gid = C.bid * 128 + C.tid; gid < 32768; gid += C.G * 128) {
            const int chain = gid >> 12, kv = gid & 4095, k = kv >> 6;
            float* hs = WSP(float, WS_HGS) + (size_t)chain * 32 * 4096 + kv; const float* hd = WSP(float, WS_HGD) + (size_t)chain * 32 * 64 + k;
            float S = 0.f;
#pragma unroll 1
            for (int c0 = 0; c0 < 32; c0 += 8) {
                float vv[8], dd[8];
#pragma unroll
                for (int i = 0; i < 8; ++i) { vv[i] = hs[(size_t)(c0 + i) * 4096]; dd[i] = hd[(c0 + i) * 64]; }
#pragma unroll
                for (int i = 0; i < 8; ++i) { hs[(size_t)(c0 + i) * 4096] = S; S = dd[i] * S + vv[i]; }
            }
            C.out[O_HSP + (size_t)(l * 8 + chain) * 4096 + kv] = S;
        }
    }
}

__device__ __forceinline__ void gmlp_prompt_item(const Ctx& C, int l, int item) {
    const int b = item >> 8, n = (item >> 2) & 63, g = item & 3;
    LAS float* Wl = (LAS float*)C.lds;
    LAS float* Vn = Wl + 128 * 129;
    __syncthreads();
    const float* Wg = IN(12) + (size_t)(l * 4 + g) * 128 * 128;
    for (int e = C.tid; e < 4096; e += 512) { const int t = e >> 5, s4 = (e & 31) * 4; const f32x4 wv = *(const f32x4*)(Wg + t * 128 + s4);
        LAS float* d = Wl + t * 129 + s4; d[0] = wv.x; d[1] = wv.y; d[2] = wv.z; d[3] = wv.w; }
    const bf16_t* P = WSP(bf16_t, WS_PROJ) + (size_t)(b * SEQ + n * 128) * DIN;
    {
        const int s = C.tid >> 2, q4 = C.tid & 3;
        const bf16_t* gp = P + (size_t)s * DIN + 1024 + q4 * 64;
        float sm = 0.f, sq = 0.f;
#pragma unroll
        for (int i = 0; i < 8; ++i) { float x[8]; unpack8(*(const u32x4*)(gp + i * 8), x);
#pragma unroll
            for (int e = 0; e < 8; ++e) { sm += x[e]; sq += x[e] * x[e]; } }
        sm += __shfl_xor(sm, 1); sm += __shfl_xor(sm, 2); sq += __shfl_xor(sq, 1); sq += __shfl_xor(sq, 2);
        const float mean = sm * (1.0f / 256.0f);
        const float var = fmaxf(sq * (1.0f / 256.0f) - mean * mean, 0.f);
        const float rstd = 1.0f / sqrtf(var + 1e-5f);
        const bf16_t* gg = P + (size_t)s * DIN + 1024 + g * 64 + q4 * 16;
        const float* lg = IN(10) + l * 256 + g * 64 + q4 * 16; const float* lb = IN(11) + l * 256 + g * 64 + q4 * 16;
#pragma unroll
        for (int i = 0; i < 2; ++i) { float x[8]; unpack8(*(const u32x4*)(gg + i * 8), x);
            const f32x4 ga = *(const f32x4*)(lg + i * 8), gb = *(const f32x4*)(lg + i * 8 + 4), ba = *(const f32x4*)(lb + i * 8), bb = *(const f32x4*)(lb + i * 8 + 4);
            LAS float* d = Vn + s * 64 + q4 * 16 + i * 8;
            *(LAS f32x4*)d = (f32x4){(x[0] - mean) * rstd * ga.x + ba.x, (x[1] - mean) * rstd * ga.y + ba.y, (x[2] - mean) * rstd * ga.z + ba.z, (x[3] - mean) * rstd * ga.w + ba.w};
            *(LAS f32x4*)(d + 4) = (f32x4){(x[4] - mean) * rstd * gb.x + bb.x, (x[5] - mean) * rstd * gb.y + bb.y, (x[6] - mean) * rstd * gb.z + bb.z, (x[7] - mean) * rstd * gb.w + bb.w}; }
    }
    __syncthreads();
    {
        const int t = C.tid >> 2, cq = C.tid & 3; const int tmax = C.wave * 16 + 15;
        f32x4 acc[4];
#pragma unroll
        for (int i = 0; i < 4; ++i) acc[i] = (f32x4){0.f, 0.f, 0.f, 0.f};
#pragma unroll 4
        for (int s = 0; s <= tmax; ++s) {
            const float wv = (s <= t) ? Wl[t * 129 + s] : 0.f;
            const LAS float* vp = Vn + s * 64 + cq * 16;
#pragma unroll
            for (int i = 0; i < 4; ++i) acc[i] += *(const LAS f32x4*)(vp + 4 * i) * wv;
        }
        const float bias = IN(13)[(l * 4 + g) * 128 + t];
        const bf16_t* up = P + (size_t)t * DIN + 768 + g * 64 + cq * 16;
        float u[16]; unpack8(*(const u32x4*)up, u); unpack8(*(const u32x4*)(up + 8), u + 8);
        float y[16];
#pragma unroll
        for (int i = 0; i < 4; ++i) { y[4 * i] = u[4 * i] * (acc[i].x + bias); y[4 * i + 1] = u[4 * i + 1] * (acc[i].y + bias); y[4 * i + 2] = u[4 * i + 2] * (acc[i].z + bias); y[4 * i + 3] = u[4 * i + 3] * (acc[i].w + bias); }
        bf16_t* op = WSP(bf16_t, WS_MIX) + (size_t)(b * SEQ + n * 128 + t) * DM + 512 + g * 64 + cq * 16;
        *(u32x4*)op = pack8(y); *(u32x4*)(op + 8) = pack8(y + 8);
    }
}

__device__ __forceinline__ void attn_sample_item(const Ctx& C, int l, int b) {
    const int hq = C.wave, lane = C.lane, kvh = hq >> 2;
    LAS float* qs = (LAS float*)C.lds + hq * 128; LAS float* ks = qs + 64;
    const bf16_t* rp = WSP(bf16_t, WS_PROJ) + (size_t)(MP + b) * DIN;
    const float* rr = WSP(float, WS_ROPE) + (size_t)8192 * 16;
    float qd = bf2f(rp[hq * 64 + lane]), kd = bf2f(rp[512 + kvh * 64 + lane]); const float vd = bf2f(rp[640 + kvh * 64 + lane]);
    {
        const float qo = __shfl_xor(qd, 8), ko = __shfl_xor(kd, 8);
        if (lane < 16) { const float cs = rr[lane & 7], sn = rr[8 + (lane & 7)];
            qd = (lane < 8) ? (qd * cs - qo * sn) : (qd * cs + qo * sn); kd = (lane < 8) ? (kd * cs - ko * sn) : (kd * cs + ko * sn); }
    }
    __syncthreads();
    qs[lane] = qd; ks[lane] = kd;
    if ((hq & 3) == 0) { C.out[O_KNEW + (size_t)((l * 128 + b) * 2 + kvh) * 64 + lane] = kd; C.out[O_VNEW + (size_t)((l * 128 + b) * 2 + kvh) * 64 + lane] = vd; }
    __syncthreads();
    const float* ck = IN(2) + ((size_t)(l * 128 + b) * 128 * 2 + kvh) * 64; const float* cv = IN(3) + ((size_t)(l * 128 + b) * 128 * 2 + kvh) * 64;
    float s0 = 0.f, s1 = 0.f;
    {
        const float* k0 = ck + (size_t)(lane + 1) * 128; const float* k1 = ck + (size_t)(lane + 65) * 128;
#pragma unroll 4
        for (int d = 0; d < 64; d += 4) { const f32x4 qv = *(const LAS f32x4*)(qs + d); const f32x4 a = *(const f32x4*)(k0 + d);
            s0 += a.x * qv.x + a.y * qv.y + a.z * qv.z + a.w * qv.w;
            f32x4 c2; if (lane < 63) c2 = *(const f32x4*)(k1 + d); else c2 = *(const LAS f32x4*)(ks + d);
            s1 += c2.x * qv.x + c2.y * qv.y + c2.z * qv.z + c2.w * qv.w; }
    }
    s0 *= 0.125f; s1 *= 0.125f;
    const float sink = IN(9)[l * 8 + hq];
    const float mx = fmaxf(wave_max(fmaxf(s0, s1)), sink);
    const float p0 = __expf(s0 - mx), p1 = __expf(s1 - mx);
    const float sum = wave_sum(p0 + p1) + __expf(sink - mx);
    float o = 0.f;
#pragma unroll 8
    for (int x = 0; x < 64; ++x) { const float pa = __shfl(p0, x); o += pa * cv[(size_t)(x + 1) * 128 + lane]; }
#pragma unroll 8
    for (int x = 0; x < 63; ++x) { const float pb = __shfl(p1, x); o += pb * cv[(size_t)(x + 65) * 128 + lane]; }
    o += __shfl(p1, 63) * vd;
    WSP(bf16_t, WS_MIX)[(size_t)(MP + b) * DM + hq * 64 + lane] = (bf16_t)f2bf(o / sum);
}
__device__ __forceinline__ void hgrn_sample_wave(const Ctx& C, int l, int wi) {
    const int b = wi >> 2, h = wi & 3, lane = C.lane;
    const bf16_t* rp = WSP(bf16_t, WS_PROJ) + (size_t)(MP + b) * DIN;
    const float lbv = hgrn_lb(C, l, h * 64 + lane);
    const float f = lbv + (1.0f - lbv) * sigmoid_f(bf2f(rp[1536 + h * 64 + lane])), kk = 1.0f - f;
    const float q = bf2f(rp[1280 + h * 64 + lane]), iv = bf2f(rp[1792 + h * 64 + lane]), cg = bf2f(rp[2048 + h * 64 + lane]);
    const float* S0 = IN(4) + (size_t)((l * 128 + b) * 4 + h) * 4096; float* So = C.out + O_HSS + (size_t)((l * 128 + b) * 4 + h) * 4096;
    float o = 0.f;
#pragma unroll 8
    for (int k = 0; k < 64; ++k) { const float fk = __shfl(f, k), kkk = __shfl(kk, k), qk = __shfl(q, k);
        const float S = fk * S0[k * 64 + lane] + kkk * iv; So[k * 64 + lane] = S; o += qk * S; }
    const float ms = wave_sum(o * o) * (1.0f / 64.0f);
    const float y = o * (1.0f / sqrtf(ms + 1e-6f)) * IN(15)[l * 64 + lane] * silu2(cg);
    WSP(bf16_t, WS_MIX)[(size_t)(MP + b) * DM + 768 + h * 64 + lane] = (bf16_t)f2bf(y);
}
__device__ __forceinline__ void gmlp_sample_wave(const Ctx& C, int l, int b) {
    const int lane = C.lane, c = 4 * lane, g = c >> 6;
    const bf16_t* rp = WSP(bf16_t, WS_PROJ) + (size_t)(MP + b) * DIN;
    const u32x2 gw = *(const u32x2*)(rp + 1024 + c), uw = *(const u32x2*)(rp + 768 + c);
    float x[4] = {bf2f(gw.x & 0xffffu), bf2f(gw.x >> 16), bf2f(gw.y & 0xffffu), bf2f(gw.y >> 16)};
    const float u[4] = {bf2f(uw.x & 0xffffu), bf2f(uw.x >> 16), bf2f(uw.y & 0xffffu), bf2f(uw.y >> 16)};
    const float mean = wave_sum(x[0] + x[1] + x[2] + x[3]) * (1.0f / 256.0f);
    float sq = 0.f;
#pragma unroll
    for (int i = 0; i < 4; ++i) { x[i] -= mean; sq += x[i] * x[i]; }
    const float rstd = 1.0f / sqrtf(wave_sum(sq) * (1.0f / 256.0f) + 1e-5f);
    const float w00 = IN(12)[(size_t)(l * 4 + g) * 128 * 128], b0 = IN(13)[(l * 4 + g) * 128];
    float vn[4], y[4];
#pragma unroll
    for (int i = 0; i < 4; ++i) { vn[i] = x[i] * rstd * IN(10)[l * 256 + c + i] + IN(11)[l * 256 + c + i]; y[i] = u[i] * (w00 * vn[i] + b0); }
    *(f32x4*)(C.out + O_GV + (size_t)(l * 128 + b) * 256 + c) = (f32x4){vn[0], vn[1], vn[2], vn[3]};
    u32x2 wv; wv.x = pk2(y[0], y[1]); wv.y = pk2(y[2], y[3]);
    *(u32x2*)(WSP(bf16_t, WS_MIX) + (size_t)(MP + b) * DM + 512 + c) = wv;
}

__device__ __forceinline__ void phase_mix1(const Ctx& C, int l) {
    for (int it = C.bid; it < 512; it += C.G) { if (it < 256) attn_prompt_item(C, l, it); else hgrn_item<1>(C, l, it - 256); }
}
__device__ __forceinline__ void phase_mix2(const Ctx& C, int l) {
    hgrn_scan(C, l);
    for (int it = C.bid; it < 720; it += C.G) {
        if (it < 512) gmlp_prompt_item(C, l, it);
        else if (it < 640) attn_sample_item(C, l, it - 512);
        else if (it < 704) hgrn_sample_wave(C, l, (it - 640) * 8 + C.wave);
        else gmlp_sample_wave(C, l, (it - 704) * 8 + C.wave);
    }
}
__device__ __forceinline__ void phase_mix3(const Ctx& C, int l) {
    for (int it = C.bid; it < 256; it += C.G) hgrn_item<2>(C, l, it);
}

#ifndef T_PRO
#define T_PRO 1
#endif
#ifndef T_G1
#define T_G1 1
#endif
#ifndef T_G2
#define T_G2 1
#endif
#ifndef T_G3
#define T_G3 1
#endif
#ifndef T_M1
#define T_M1 1
#endif
#ifndef T_M2
#define T_M2 1
#endif
#ifndef T_M3
#define T_M3 1
#endif
__global__ void __launch_bounds__(512, 2) mega_fwd(Args args) {
    extern __shared__ __attribute__((aligned(16))) unsigned char lds[];
    Ctx C;
    C.lds = (LAS unsigned char*)lds; C.tid = threadIdx.x; C.lane = C.tid & 63; C.wave = __builtin_amdgcn_readfirstlane(C.tid >> 6);
    C.G = gridDim.x; C.bid = blockIdx.x; C.in = args.in; C.out = args.out; C.ws = args.ws;
    cg::grid_group grid = cg::this_grid();
    const Ctx C0 = C;
    for (int ph = args.ph_lo; ph < args.ph_hi; ++ph) {
        {
            int z_; int t_ = C0.tid;
            asm volatile("s_mov_b32 %0, 0" : "=s"(z_)); asm volatile("" : "+v"(t_));
            C.ws = C0.ws + z_; C.out = C0.out + z_; C.in = C0.in + z_; C.tid = t_; C.lane = t_ & 63;
        }
        if (ph == 0) { if (T_PRO) phase_prologue(C); }
        else if (ph == 1) phase_mod0(C);
        else {
            const int l = (ph - 2) / 12, s = (ph - 2) % 12;
            if (T_G1 && (s == 0 || s == 9 || s == 1 || s == 10 || s == 7 || s == 3)) {
                const int f2 = (s >= 9) ? 1 : 0, mi = l * 2 + f2;
                pg8::Gemm g; pg8::EpiMulti E; E.O = nullptr; E.ldc = 0; E.X = nullptr; E.gate = nullptr; E.scale = 0.f;
                if (s == 0 || s == 9) {
                    g = pg8::Gemm{WSP(pg8::bf16_t, WS_H), WSP(pg8::bf16_t, WS_FFIN) + (size_t)mi * 2 * DFF * DM, MPAD, 2 * DFF, DM};
                    E.mode = 0; E.O = WSP(pg8::bf16_t, WS_ACT); E.ldc = DFF;
                } else if (s == 1 || s == 10) {
                    g = pg8::Gemm{WSP(pg8::bf16_t, WS_ACT), WSP(pg8::bf16_t, WS_FFOUT) + (size_t)mi * DM * DFF, MPAD, DM, DFF};
                    E.mode = 2; E.X = C.out; E.gate = WSP(float, WS_MOD) + (size_t)l * NCROW * MODW + (size_t)(s == 1 ? 2 : 8) * DM; E.scale = 0.5f;
                } else if (s == 7) {
                    g = pg8::Gemm{WSP(pg8::bf16_t, WS_MIX), WSP(pg8::bf16_t, WS_WOUT) + (size_t)l * DM * DM, MPAD, DM, DM};
                    E.mode = 2; E.X = C.out; E.gate = WSP(float, WS_MOD) + (size_t)l * NCROW * MODW + (size_t)5 * DM; E.scale = 1.0f;
                } else {
                    g = pg8::Gemm{WSP(pg8::bf16_t, WS_H), WSP(pg8::bf16_t, WS_WIN) + (size_t)l * DIN * DM, MPAD, DIN, DM};
                    E.mode = 1; E.O = WSP(pg8::bf16_t, WS_PROJ); E.ldc = DIN;
                }
                pg8::StaticOrder S; S.init(g.M, g.N, C.G, C.bid);
                pg8::gemm_phase<pg8::EpiMulti, pg8::StaticOrder, true, true>(C.lds, g, S, E);
            } else if (s == 2) phase_ln(C, l, 0);
            else if (s == 8) phase_ln(C, l, 1);
            else if (s == 11) phase_ln(C, l, 2);
            else if (s == 4) { if (T_M1) phase_mix1(C, l); }
            else if (s == 5) { if (T_M2) phase_mix2(C, l); }
            else { if (T_M3) phase_mix3(C, l); }
        }
        if (ph + 1 < args.ph_hi) grid.sync();
    }
}

#ifndef MK_ONE_LAUNCH
#define MK_ONE_LAUNCH 0
#endif
extern "C" void kernel_launch(void* const* d_in, const int* in_sizes, int n_in, void* d_out, int out_size, void* d_ws, size_t ws_size, hipStream_t stream) {
    static int grid = 0;
    if (grid == 0) {
        if (n_in != 24 || ws_size < WS_END) { fprintf(stderr, "kernel_launch: unexpected n_in %d / ws %zu\n", n_in, ws_size); grid = -1; return; }
        int dev = 0, cus = 0, per_cu = 0;
        (void)hipGetDevice(&dev); (void)hipDeviceGetAttribute(&cus, hipDeviceAttributeMultiprocessorCount, dev);
        if (hipFuncSetAttribute((const void*)mega_fwd, hipFuncAttributeMaxDynamicSharedMemorySize, LDS_BYTES) != hipSuccess) { fprintf(stderr, "kernel_launch: hipFuncSetAttribute failed\n"); grid = -1; return; }
        if (hipOccupancyMaxActiveBlocksPerMultiprocessor(&per_cu, (const void*)mega_fwd, 512, LDS_BYTES) != hipSuccess || per_cu < 1) { fprintf(stderr, "kernel_launch: occupancy query gave %d\n", per_cu); per_cu = 1; }
        (void)hipGetLastError();
        grid = cus > 0 ? cus : 256;
    }
    if (grid < 0) return;
    Args a{};
    for (int i = 0; i < 24; ++i) a.in[i] = (const float*)d_in[i];
    a.out = (float*)d_out; a.ws = (unsigned char*)d_ws;
#if MK_ONE_LAUNCH
    a.ph_lo = 0; a.ph_hi = NPH;
    void* kargs[] = {&a};
    hipError_t e = hipLaunchCooperativeKernel((const void*)mega_fwd, dim3(grid), dim3(512), kargs, LDS_BYTES, stream);
    if (e != hipSuccess) fprintf(stderr, "kernel_launch: cooperative launch failed: %s (grid %d)\n", hipGetErrorString(e), grid);
#else
    for (int ph = 0; ph < NPH; ++ph) { a.ph_lo = ph; a.ph_hi = ph + 1; hipLaunchKernelGGL(mega_fwd, dim3(grid), dim3(512), LDS_BYTES, stream, a); }
#endif
}
```

```cpp
#include <hip/hip_runtime.h>
#include <hip/hip_cooperative_groups.h>
#include <cstdio>
#include <cstdint>
namespace cg = cooperative_groups;

constexpr int DM = 1024, SEQ = 8192, MP = 16384, DECB = 128, MR = MP + DECB, MPAD = 16640;
constexpr int DIN = 2304, DFF = 2816, MODW = 9216, NCROW = 130, DEPTH = 2;
constexpr float ALPHA_F = 1.41421356237f;
__device__ __forceinline__ int crow_of(int r) { return r < MP ? (r >> 13) : (r < MR ? 2 + (r - MP) : 129); }

namespace pg8 {
#define PG8_LAS __attribute__((address_space(3)))
typedef unsigned short bf16_t;
typedef short bf16x8 __attribute__((ext_vector_type(8)));
typedef float f32x4 __attribute__((ext_vector_type(4)));
typedef unsigned u32x4 __attribute__((ext_vector_type(4)));
constexpr int BM = 256, BK = 64, HALF = 128, HTB = HALF * BK * 2  , STAGE_BYTES = 8 * HTB, NXCD = 8, WGM = 8;

__host__ __device__ __forceinline__ int lds_byte(int r, int c) { const int st = (r >> 4) * 2 + (c >> 5), rr = r & 15, cc = c & 31, ob = rr * 64 + cc * 2; return st * 1024 + (ob ^ (((ob >> 9) & 1) << 5)); }
__host__ __device__ __forceinline__ void stage_rc(int b, int& R, int& C) { const int st = b / 1024, sb = b % 1024, swz = sb ^ (((sb >> 9) & 1) << 5); R = (st >> 1) * 16 + swz / 64; C = (st & 1) * 32 + (swz % 64) / 2; }
__host__ __device__ __forceinline__ int perm32(int rho) { const int n = rho >> 4, i = rho & 15; return 8 * (i >> 2) + 4 * n + (i & 3); }

struct Unit { int pm, pn; };
struct Gemm { const bf16_t* A; const bf16_t* Bt; int M, N, K; };

struct StaticOrder {
    int nM, nN, nwg, G, c;
    __host__ __device__ void init(int M, int N, int G_, int c_) { nM = M / BM; nN = N / BM; nwg = nM * nN; G = G_; c = c_; }
    __host__ __device__ bool next(int i, Unit& u) const {
        const long L = (long)i * G + c; if (L >= nwg) return false;
        int wgid = (int)L; { const int q = nwg / NXCD, r = nwg % NXCD, xcd = wgid % NXCD, off = wgid / NXCD; wgid = (xcd < r ? xcd * (q + 1) : r * (q + 1) + (xcd - r) * q) + off; }
        const int nig = WGM * nN, gid = wgid / nig, fm = gid * WGM, gsz = (nM - fm) < WGM ? (nM - fm) : WGM;
        u.pm = fm + ((wgid % nig) % gsz); u.pn = (wgid % nig) / gsz; return true;
    }
    __device__ __forceinline__ void a_ready(const Unit&) const {}
    __device__ __forceinline__ void done(const Unit&) const {}
};

__device__ __forceinline__ unsigned cvt_pk_bf16(float lo, float hi) { unsigned r; asm volatile("v_cvt_pk_bf16_f32 %0, %1, %2" : "=v"(r) : "v"(lo), "v"(hi)); return r; }
typedef float f32x2 __attribute__((ext_vector_type(2)));

__device__ __forceinline__ float silu_f(float g) { return g * __builtin_amdgcn_rcpf(1.0f + __expf(-g)); }
struct EpiSwiglu {
    static constexpr bool PERM = true, AFTER_DRAIN = false;
    bf16_t* O;
    __device__ __forceinline__ void operator()(const f32x4 (&acc)[2][2][4][2], const Unit& u, int wr, int wc, int fr, int fq) const {
        const int row0 = u.pm * BM + wr * 64 + fr, col0 = u.pn * HALF + wc * 32 + 8 * fq;
#pragma unroll
        for (int ai = 0; ai < 2; ++ai)
#pragma unroll
            for (int m = 0; m < 4; ++m) {
                bf16_t* rowp = O + (size_t)(row0 + ai * HALF + m * 16) * DFF + col0;
                const f32x4 a0 = acc[ai][0][m][0], a1 = acc[ai][0][m][1], g0 = acc[ai][1][m][0], g1 = acc[ai][1][m][1];
                u32x4 w;
                w.x = cvt_pk_bf16(silu_f(g0[0]) * a0[0], silu_f(g0[1]) * a0[1]); w.y = cvt_pk_bf16(silu_f(g0[2]) * a0[2], silu_f(g0[3]) * a0[3]);
                w.z = cvt_pk_bf16(silu_f(g1[0]) * a1[0], silu_f(g1[1]) * a1[1]); w.w = cvt_pk_bf16(silu_f(g1[2]) * a1[2], silu_f(g1[3]) * a1[3]);
                *(u32x4*)rowp = w;
            }
    }
};
struct EpiStore {
    static constexpr bool PERM = true, AFTER_DRAIN = false;
    bf16_t* O; int ldc;
    __device__ __forceinline__ void operator()(const f32x4 (&acc)[2][2][4][2], const Unit& u, int wr, int wc, int fr, int fq) const {
        const int row0 = u.pm * BM + wr * 64 + fr, col0 = u.pn * BM + wc * 32 + 8 * fq;
#pragma unroll
        for (int ai = 0; ai < 2; ++ai)
#pragma unroll
            for (int m = 0; m < 4; ++m) {
                bf16_t* rowp = O + (size_t)(row0 + ai * HALF + m * 16) * ldc + col0;
#pragma unroll
                for (int bj = 0; bj < 2; ++bj) {
                    const f32x4 v0 = acc[ai][bj][m][0], v1 = acc[ai][bj][m][1];
                    u32x4 w; w.x = cvt_pk_bf16(v0[0], v0[1]); w.y = cvt_pk_bf16(v0[2], v0[3]); w.z = cvt_pk_bf16(v1[0], v1[1]); w.w = cvt_pk_bf16(v1[2], v1[3]);
                    *(u32x4*)(rowp + bj * HALF) = w;
                }
            }
    }
};
struct EpiResid {
    static constexpr bool PERM = false, AFTER_DRAIN = false;
    float* X; const float* gate; float scale;
    __device__ __forceinline__ void operator()(const f32x4 (&acc)[2][2][4][2], const Unit& u, int wr, int wc, int fr, int fq) const {
#pragma unroll
        for (int ai = 0; ai < 2; ++ai)
#pragma unroll
            for (int m = 0; m < 4; ++m) {
                const int r = u.pm * BM + ai * HALF + wr * 64 + m * 16 + fr;
                if (r < MR) {
                    const float* gp = gate + (size_t)crow_of(r) * MODW; float* xp = X + (size_t)r * DM;
#pragma unroll
                    for (int bj = 0; bj < 2; ++bj)
#pragma unroll
                        for (int n = 0; n < 2; ++n) {
                            const int c = u.pn * BM + bj * HALF + wc * 32 + n * 16 + 4 * fq;
                            const f32x4 gv = *(const f32x4*)(gp + c); const f32x4 xv = *(const f32x4*)(xp + c);
                            *(f32x4*)(xp + c) = xv * ALPHA_F + (gv + 1.0f) * (acc[ai][bj][m][n] * scale);
                        }
                }
            }
    }
};

struct EpiMulti {
    static constexpr bool PERM = true, AFTER_DRAIN = false;
    int mode; bf16_t* O; int ldc; bf16_t* X; bf16_t* Xw; const float* gate; float scale;
    const float* Xf; const float* ST; const float* pg; const float* pb;
    __device__ __forceinline__ void operator()(const f32x4 (&acc)[2][2][4][2], const Unit& u, int wr, int wc, int fr, int fq) const {
        if (mode == 0) { EpiSwiglu e{O}; e(acc, u, wr, wc, fr, fq); }
        else { EpiStore e{O, ldc}; e(acc, u, wr, wc, fr, fq); }
    }
    __device__ __forceinline__ bool after_drain() const { return mode == 2; }
    __device__ __forceinline__ void fused(const f32x4 (&acc)[2][2][4][2], const Unit& u, int wr, int wc, int fr, int fq, PG8_LAS unsigned char*, int, int) const {
        {
            const int r0 = u.pm * BM + wr * 64 + fr, cb = u.pn * BM + wc * 32 + 8 * fq;
            const float* gp = gate + (size_t)crow_of(u.pm * BM) * MODW + cb;
            f32x4 G[2][2];
#pragma unroll
            for (int bj = 0; bj < 2; ++bj) { G[bj][0] = *(const f32x4*)(gp + bj * HALF) + 1.0f; G[bj][1] = *(const f32x4*)(gp + bj * HALF + 4) + 1.0f; }
            if (Xf != nullptr) {
#pragma unroll
                for (int ai = 0; ai < 2; ++ai)
#pragma unroll
                    for (int m = 0; m < 4; ++m) { const int r = r0 + ai * HALF + m * 16;
#pragma unroll
                        for (int bj = 0; bj < 2; ++bj) { const float* sp = Xf + (size_t)r * DM + cb + bj * HALF;
                            const f32x4 z0 = *(const f32x4*)sp * ALPHA_F + G[bj][0] * (acc[ai][bj][m][0] * scale), z1 = *(const f32x4*)(sp + 4) * ALPHA_F + G[bj][1] * (acc[ai][bj][m][1] * scale);
                            u32x4 o; o.x = cvt_pk_bf16(z0[0], z0[1]); o.y = cvt_pk_bf16(z0[2], z0[3]); o.z = cvt_pk_bf16(z1[0], z1[1]); o.w = cvt_pk_bf16(z1[2], z1[3]);
                            *(u32x4*)(Xw + (size_t)r * DM + cb + bj * HALF) = o; } }
            } else {
#pragma unroll
                for (int bj = 0; bj < 2; ++bj) {
                    const int cc = cb + bj * HALF;
                    const f32x4 PG0 = *(const f32x4*)(pg + cc), PG1 = *(const f32x4*)(pg + cc + 4), PB0 = *(const f32x4*)(pb + cc), PB1 = *(const f32x4*)(pb + cc + 4);
                    u32x4 nx = *(const u32x4*)(X + (size_t)r0 * DM + cc); float nmean = ST[2 * r0], nrstd = ST[2 * r0 + 1];
#pragma unroll
                    for (int idx = 0; idx < 8; ++idx) {
                        const int ai = idx >> 2, m = idx & 3, r = r0 + ai * HALF + m * 16;
                        const u32x4 w = nx; const float mean = nmean, rstd = nrstd;
                        if (idx < 7) { const int rn = r0 + ((idx + 1) >> 2) * HALF + ((idx + 1) & 3) * 16; nx = *(const u32x4*)(X + (size_t)rn * DM + cc); nmean = ST[2 * rn]; nrstd = ST[2 * rn + 1]; }
                        f32x4 x0 = (f32x4){__uint_as_float(w.x << 16), __uint_as_float(w.x & 0xffff0000u), __uint_as_float(w.y << 16), __uint_as_float(w.y & 0xffff0000u)};
                        f32x4 x1 = (f32x4){__uint_as_float(w.z << 16), __uint_as_float(w.z & 0xffff0000u), __uint_as_float(w.w << 16), __uint_as_float(w.w & 0xffff0000u)};
                        x0 = (x0 - mean) * rstd * PG0 + PB0; x1 = (x1 - mean) * rstd * PG1 + PB1;
                        const f32x4 z0 = x0 * ALPHA_F + G[bj][0] * (acc[ai][bj][m][0] * scale), z1 = x1 * ALPHA_F + G[bj][1] * (acc[ai][bj][m][1] * scale);
                        u32x4 o; o.x = cvt_pk_bf16(z0[0], z0[1]); o.y = cvt_pk_bf16(z0[2], z0[3]); o.z = cvt_pk_bf16(z1[0], z1[1]); o.w = cvt_pk_bf16(z1[2], z1[3]);
                        *(u32x4*)(Xw + (size_t)r * DM + cc) = o;
                        asm volatile("" ::: "memory");
                    }
                }
            }
        }
    }
};
template <class Epi, class Sched, bool ALIGN_EPI = false, bool SP2 = false>
__device__ __forceinline__ void gemm_phase(PG8_LAS unsigned char* lds, const Gemm g, const Sched& S, const Epi& E) {
    const int tid = threadIdx.x, wid = __builtin_amdgcn_readfirstlane(tid >> 6), lane = tid & 63, wr = wid >> 2, wc = wid & 3, fr = lane & 15, fq = lane >> 4;
    const int K = g.K, nt = K / BK;
    unsigned voffA[2], voffB[2];
#pragma unroll
    for (int i = 0; i < 2; ++i) { int R, C; stage_rc(tid * 16 + i * 8192, R, C); const int Rb = Epi::PERM ? ((R & ~31) + perm32(R & 31)) : R;
        voffA[i] = (unsigned)(R * K + C) * 2u; voffB[i] = (unsigned)(Rb * K + C) * 2u; }
    const size_t kstep = (size_t)(BK * 2);
    const size_t hstep = (size_t)HALF * K * 2;
    const size_t tstep = 2 * hstep;
    const unsigned ldsw = (unsigned)wid * 1024u;
    const int aoff = lds_byte(wr * 64 + fr, fq * 8), boff = lds_byte(wc * 32 + fr, fq * 8);
#define PG8_SA(b, h) (((b) * 2 + (h)) * HTB)
#define PG8_SB(b, h) ((4 + (b) * 2 + (h)) * HTB)
#define PG8_STAGE(bufoff, gbase, voff) do { _Pragma("unroll") for (int _i = 0; _i < 2; ++_i) \
        __builtin_amdgcn_global_load_lds((const unsigned*)((const char*)(gbase) + (voff)[_i]), (PG8_LAS unsigned*)(lds + (bufoff) + ldsw + _i * 8192), 16, 0, 0); } while (0)
#define PG8_LDA(dst, b, h) do { _Pragma("unroll") for (int m = 0; m < 4; ++m) _Pragma("unroll") for (int k = 0; k < 2; ++k) dst[m][k] = *(const PG8_LAS bf16x8*)(lds + PG8_SA(b, h) + aoff + m * 2048 + k * 1024); } while (0)
#define PG8_LDB(dst, b, h) do { _Pragma("unroll") for (int n = 0; n < 2; ++n) _Pragma("unroll") for (int k = 0; k < 2; ++k) dst[n][k] = *(const PG8_LAS bf16x8*)(lds + PG8_SB(b, h) + boff + n * 2048 + k * 1024); } while (0)
#define PG8_MMA(ai, bj, At, Bt) do { __builtin_amdgcn_s_setprio(1); _Pragma("unroll") for (int m = 0; m < 4; ++m) _Pragma("unroll") for (int n = 0; n < 2; ++n) _Pragma("unroll") for (int k = 0; k < 2; ++k) \
        acc[ai][bj][m][n] = __builtin_amdgcn_mfma_f32_16x16x32_bf16(Bt[n][k], At[m][k], acc[ai][bj][m][n], 0, 0, 0); __builtin_amdgcn_s_setprio(0); } while (0)
#define PG8_WAIT_V(n) asm volatile("s_waitcnt vmcnt(" #n ")" ::: "memory")
#define PG8_WAIT_L(n) asm volatile("s_waitcnt lgkmcnt(" #n ")" ::: "memory")
#define PG8_BAR __builtin_amdgcn_s_barrier()
#define PG8_SCHED __builtin_amdgcn_sched_barrier(0)
    Unit cur, nxt; int ui = 0;
    if (!S.next(0, cur)) return;
    f32x4 acc[2][2][4][2];
#pragma unroll
    for (int a = 0; a < 2; ++a)
#pragma unroll
        for (int b = 0; b < 2; ++b)
#pragma unroll
            for (int m = 0; m < 4; ++m)
#pragma unroll
                for (int n = 0; n < 2; ++n) acc[a][b][m][n] = (f32x4){0.f, 0.f, 0.f, 0.f};
    bf16x8 At[4][2], B0[2][2], B1[2][2];
    const char* cA = (const char*)g.A + (size_t)cur.pm * tstep; const char* cB = (const char*)g.Bt + (size_t)cur.pn * tstep;
    S.a_ready(cur);
    if constexpr (SP2) {
        PG8_STAGE(PG8_SB(0, 0), cB, voffB); PG8_STAGE(PG8_SB(0, 1), cB + hstep, voffB); PG8_STAGE(PG8_SA(0, 0), cA, voffA); PG8_STAGE(PG8_SA(0, 1), cA + hstep, voffA);
        if (wr == 1) PG8_BAR;
        PG8_WAIT_V(2); PG8_BAR;
        PG8_STAGE(PG8_SB(1, 0), cB + kstep, voffB); PG8_STAGE(PG8_SA(1, 0), cA + kstep, voffA); PG8_STAGE(PG8_SB(1, 1), cB + hstep + kstep, voffB);
        PG8_WAIT_V(6); PG8_BAR;
    } else {
        PG8_STAGE(PG8_SB(0, 0), cB, voffB); PG8_STAGE(PG8_SA(0, 0), cA, voffA); PG8_STAGE(PG8_SB(0, 1), cB + hstep, voffB); PG8_STAGE(PG8_SA(0, 1), cA + hstep, voffA);
        if (wr == 1) PG8_BAR;
        PG8_WAIT_V(4); PG8_BAR;
        PG8_STAGE(PG8_SB(1, 0), cB + kstep, voffB); PG8_STAGE(PG8_SA(1, 0), cA + kstep, voffA); PG8_STAGE(PG8_SB(1, 1), cB + hstep + kstep, voffB);
        PG8_WAIT_V(6); PG8_BAR;
    }
    for (;;) {
        const bool has_next = S.next(ui + 1, nxt);
        const char* nA = has_next ? (const char*)g.A + (size_t)nxt.pm * tstep : cA; const char* nB = has_next ? (const char*)g.Bt + (size_t)nxt.pn * tstep : cB;
        for (int t = 0; t < nt; t += 2) {
            const bool last = (t == nt - 2);
            const char* a1 = cA + (size_t)(t + 1) * kstep;
            const char* a2 = last ? nA : cA + (size_t)(t + 2) * kstep; const char* b2 = last ? nB : cB + (size_t)(t + 2) * kstep;
            const char* a3 = a2 + kstep; const char* b3 = b2 + kstep;
            if (last && has_next) S.a_ready(nxt);
            if constexpr (SP2) {
            PG8_LDB(B0, 0, 0); PG8_LDB(B1, 0, 1); PG8_SCHED; PG8_LDA(At, 0, 0); PG8_STAGE(PG8_SA(1, 1), a1 + hstep, voffA);
            PG8_WAIT_V(8); PG8_WAIT_L(0); PG8_BAR; PG8_MMA(0, 0, At, B0); PG8_MMA(0, 1, At, B1); PG8_BAR; PG8_SCHED;
            PG8_LDA(At, 0, 1); PG8_STAGE(PG8_SB(0, 0), b2, voffB); PG8_STAGE(PG8_SB(0, 1), b2 + hstep, voffB); PG8_STAGE(PG8_SA(0, 0), a2, voffA);
            PG8_WAIT_V(8); PG8_WAIT_L(0); PG8_BAR; PG8_MMA(1, 0, At, B0); PG8_MMA(1, 1, At, B1); PG8_BAR; PG8_SCHED;
            PG8_LDB(B0, 1, 0); PG8_LDB(B1, 1, 1); PG8_SCHED; PG8_LDA(At, 1, 0); PG8_STAGE(PG8_SA(0, 1), a2 + hstep, voffA);
            PG8_WAIT_V(8); PG8_WAIT_L(0); PG8_BAR; PG8_MMA(0, 0, At, B0); PG8_MMA(0, 1, At, B1); PG8_BAR; PG8_SCHED;
            PG8_LDA(At, 1, 1); PG8_STAGE(PG8_SB(1, 0), b3, voffB); PG8_STAGE(PG8_SB(1, 1), b3 + hstep, voffB); PG8_STAGE(PG8_SA(1, 0), a3, voffA);
            PG8_WAIT_V(8); PG8_WAIT_L(0); PG8_BAR; PG8_MMA(1, 0, At, B0); PG8_MMA(1, 1, At, B1); PG8_BAR; PG8_SCHED;
            } else {
            PG8_LDB(B0, 0, 0); PG8_SCHED; PG8_LDA(At, 0, 0); PG8_STAGE(PG8_SA(1, 1), a1 + hstep, voffA);
            PG8_WAIT_L(8); PG8_BAR; PG8_WAIT_L(0); PG8_MMA(0, 0, At, B0); PG8_BAR; PG8_SCHED;
            PG8_LDB(B1, 0, 1); PG8_STAGE(PG8_SB(0, 0), b2, voffB);
            PG8_BAR; PG8_WAIT_L(0); PG8_MMA(0, 1, At, B1); PG8_BAR;
            PG8_LDA(At, 0, 1); PG8_STAGE(PG8_SA(0, 0), a2, voffA);
            PG8_BAR; PG8_WAIT_L(0); PG8_MMA(1, 0, At, B0); PG8_BAR; PG8_SCHED;
            PG8_STAGE(PG8_SB(0, 1), b2 + hstep, voffB);
            PG8_WAIT_V(6); PG8_BAR; PG8_MMA(1, 1, At, B1); PG8_BAR;
            PG8_LDB(B0, 1, 0); PG8_SCHED; PG8_LDA(At, 1, 0); PG8_STAGE(PG8_SA(0, 1), a2 + hstep, voffA);
            PG8_WAIT_L(8); PG8_BAR; PG8_WAIT_L(0); PG8_MMA(0, 0, At, B0); PG8_BAR; PG8_SCHED;
            PG8_LDB(B1, 1, 1); PG8_STAGE(PG8_SB(1, 0), b3, voffB);
            PG8_BAR; PG8_WAIT_L(0); PG8_MMA(0, 1, At, B1); PG8_BAR;
            PG8_LDA(At, 1, 1); PG8_STAGE(PG8_SA(1, 0), a3, voffA);
            PG8_BAR; PG8_WAIT_L(0); PG8_MMA(1, 0, At, B0); PG8_BAR; PG8_SCHED;
            PG8_STAGE(PG8_SB(1, 1), b3 + hstep, voffB);
            PG8_WAIT_V(6); PG8_BAR; PG8_MMA(1, 1, At, B1); PG8_BAR;
            }
        }
        if constexpr (ALIGN_EPI) { if (wr == 0) PG8_BAR; }
        if (!E.after_drain()) { E(acc, cur, wr, wc, fr, fq); S.done(cur); }
        if (!has_next) break;
#pragma unroll
        for (int a = 0; a < 2; ++a)
#pragma unroll
            for (int b = 0; b < 2; ++b)
#pragma unroll
                for (int m = 0; m < 4; ++m)
#pragma unroll
                    for (int n = 0; n < 2; ++n) acc[a][b][m][n] = (f32x4){0.f, 0.f, 0.f, 0.f};
        cur = nxt; cA = nA; cB = nB; ++ui;
        if constexpr (ALIGN_EPI) { if (wr == 1) PG8_BAR; }
    }
    PG8_WAIT_V(0);
    if constexpr (!ALIGN_EPI) { if (wr == 0) PG8_BAR; }
    PG8_BAR;
    if (E.after_drain()) { E.fused(acc, cur, wr, wc, fr, fq, lds, wid, lane); S.done(cur); }
#undef PG8_SA
#undef PG8_SB
#undef PG8_STAGE
#undef PG8_LDA
#undef PG8_LDB
#undef PG8_MMA
#undef PG8_WAIT_V
#undef PG8_WAIT_L
#undef PG8_BAR
#undef PG8_SCHED
}
}

constexpr size_t MiB = 1u << 20;
constexpr size_t WS_FFIN = 1 * MiB;
constexpr size_t WS_FFOUT = 45 * MiB;
constexpr size_t WS_WIN = 67 * MiB;
constexpr size_t WS_WOUT = 76 * MiB;
constexpr size_t WS_MOD = 80 * MiB;
constexpr size_t WS_ROPE = 90 * MiB;
constexpr size_t WS_H = 91 * MiB;
constexpr size_t WS_ACT = 124 * MiB;
constexpr size_t WS_PROJ = 124 * MiB;
constexpr size_t WS_MIX = 198 * MiB;
constexpr size_t WS_HGS = 297 * MiB;
constexpr size_t WS_HGD = 235 * MiB;
constexpr size_t WS_YS = 236 * MiB;
constexpr size_t WS_ST = 238 * MiB;
constexpr size_t WS_XB = 240 * MiB;
constexpr size_t WS_OL = 273 * MiB;
constexpr size_t WS_QT = 289 * MiB;
constexpr size_t WS_END = 305 * MiB;
constexpr size_t O_Y = 0, O_KWIN = 16908288, O_VWIN = 16973824, O_HSP = 17039360, O_KNEW = 17104896, O_VNEW = 17137664, O_GV = 17170432, O_HSS = 17235968;

constexpr int LDS_BYTES = 147456;
constexpr int NPH = 26;

#define LAS __attribute__((address_space(3)))
typedef unsigned short bf16_t;
typedef short bf16x8 __attribute__((ext_vector_type(8)));
typedef float f32x4 __attribute__((ext_vector_type(4)));
typedef unsigned u32x4 __attribute__((ext_vector_type(4)));
typedef unsigned u32x2 __attribute__((ext_vector_type(2)));

__device__ __forceinline__ float bf2f(unsigned h) { return __uint_as_float(h << 16); }
__device__ __forceinline__ unsigned f2bf(float f) { unsigned u = __float_as_uint(f); return (u + 0x7fffu + ((u >> 16) & 1u)) >> 16; }
__device__ __forceinline__ unsigned pk2(float lo, float hi) { return f2bf(lo) | (f2bf(hi) << 16); }
__device__ __forceinline__ void unpack8(const u32x4 w, float* x) {
    x[0] = __uint_as_float(w.x << 16); x[1] = __uint_as_float(w.x & 0xffff0000u); x[2] = __uint_as_float(w.y << 16); x[3] = __uint_as_float(w.y & 0xffff0000u);
    x[4] = __uint_as_float(w.z << 16); x[5] = __uint_as_float(w.z & 0xffff0000u); x[6] = __uint_as_float(w.w << 16); x[7] = __uint_as_float(w.w & 0xffff0000u);
}
__device__ __forceinline__ u32x4 pack8(const float* x) { u32x4 w; w.x = pk2(x[0], x[1]); w.y = pk2(x[2], x[3]); w.z = pk2(x[4], x[5]); w.w = pk2(x[6], x[7]); return w; }
__device__ __forceinline__ float sigmoid_f(float x) { return 1.0f / (1.0f + __expf(-x)); }
__device__ __forceinline__ float silu2(float x) { return x * __builtin_amdgcn_rcpf(1.0f + __expf(-x)); }
__device__ __forceinline__ float wave_sum(float v) {
#pragma unroll
    for (int o = 1; o < 64; o <<= 1) v += __shfl_xor(v, o);
    return v;
}
__device__ __forceinline__ float wave_max(float v) {
#pragma unroll
    for (int o = 1; o < 64; o <<= 1) v = fmaxf(v, __shfl_xor(v, o));
    return v;
}

struct Args { const float* in[24]; float* out; unsigned char* ws; int ph_lo, ph_hi; };

struct Ctx {
    LAS unsigned char* lds;
    int tid, lane, wave, G, bid;
    const float* const* in;
    float* out; unsigned char* ws;
};
#define IN(i) (C.in[i])
#define WSP(T, off) ((T*)(C.ws + (off)))

__device__ __forceinline__ void transpose_item(const float* W, int K, int N, bf16_t* WT, int k0, int n0, int drow, LAS float* scr, int lane) {
    f32x4 v[16];
    const float* src = W + (size_t)(k0 + (lane >> 4)) * N + n0 + (lane & 15) * 4;
#pragma unroll
    for (int i = 0; i < 16; ++i) v[i] = *(const f32x4*)(src + (size_t)(4 * i) * N);
#pragma unroll
    for (int i = 0; i < 16; ++i) { LAS float* d = scr + (4 * i + (lane >> 4)) * 65 + (lane & 15) * 4; d[0] = v[i].x; d[1] = v[i].y; d[2] = v[i].z; d[3] = v[i].w; }
    asm volatile("s_waitcnt lgkmcnt(0)" ::: "memory");
    const int c = lane & 7;
#pragma unroll
    for (int j = 0; j < 8; ++j) { const int n = (lane >> 3) + 8 * j; const LAS float* s = scr + (8 * c) * 65 + n;
        u32x4 o; o.x = pk2(s[0 * 65], s[1 * 65]); o.y = pk2(s[2 * 65], s[3 * 65]); o.z = pk2(s[4 * 65], s[5 * 65]); o.w = pk2(s[6 * 65], s[7 * 65]);
        *(u32x4*)(WT + (size_t)(drow + n) * K + k0 + 8 * c) = o; }
    asm volatile("s_waitcnt lgkmcnt(0)" ::: "memory");
}
constexpr int N_TR_LAYER = 2 * 16 * 88 + 2 * 44 * 16 + 16 * 36 + 16 * 16;
__device__ __forceinline__ void transpose_dispatch(const Ctx& C, int l, int it) {
    LAS float* scr = (LAS float*)(C.lds + C.wave * 16640);
    constexpr int I_FI = 16 * 88, I_FO = 44 * 16, I_WI = 16 * 36, I_WO = 16 * 16;
    int r = it;
    if (r < 2 * I_FI) { const int f = r / I_FI, q = r % I_FI, mi = l * 2 + f; const int kb = q / 88, nb = q % 88, n0 = nb * 64;
        const int half = n0 >= DFF ? 1 : 0, j0 = n0 - half * DFF, drow = 256 * (j0 >> 7) + 128 * half + (j0 & 127);
        transpose_item(IN(f ? 18 : 16) + (size_t)l * DM * 2 * DFF, DM, 2 * DFF, WSP(bf16_t, WS_FFIN) + (size_t)mi * 2 * DFF * DM, kb * 64, n0, drow, scr, C.lane); return; }
    r -= 2 * I_FI;
    if (r < 2 * I_FO) { const int f = r / I_FO, q = r % I_FO, mi = l * 2 + f; const int kb = q / 16, nb = q % 16;
        transpose_item(IN(f ? 19 : 17) + (size_t)l * DFF * DM, DFF, DM, WSP(bf16_t, WS_FFOUT) + (size_t)mi * DM * DFF, kb * 64, nb * 64, nb * 64, scr, C.lane); return; }
    r -= 2 * I_FO;
    if (r < I_WI) { const int q = r; const int kb = q / 36, nb = q % 36;
        transpose_item(IN(7) + (size_t)l * DM * DIN, DM, DIN, WSP(bf16_t, WS_WIN) + (size_t)l * DIN * DM, kb * 64, nb * 64, nb * 64, scr, C.lane); return; }
    r -= I_WI;
    if (r < I_WO) { const int q = r; const int kb = q / 16, nb = q % 16;
        transpose_item(IN(8) + (size_t)l * DM * DM, DM, DM, WSP(bf16_t, WS_WOUT) + (size_t)l * DM * DM, kb * 64, nb * 64, nb * 64, scr, C.lane); }
}
__device__ __forceinline__ void ada_item(const Ctx& C, int item) {
    LAS bf16_t* As = (LAS bf16_t*)C.lds;
    const int l = item / 72, n0 = (item % 72) * 128 + C.wave * 16, lane = C.lane, fr = lane & 15, fq = lane >> 4;
    const float* W = IN(20) + (size_t)l * DM * MODW + n0 + fr;
    f32x4 acc[9];
#pragma unroll
    for (int i = 0; i < 9; ++i) acc[i] = (f32x4){0.f, 0.f, 0.f, 0.f};
#pragma unroll 1
    for (int kc = 0; kc < 4; ++kc) {
        __syncthreads();
        for (int e = C.tid; e < 144 * 32; e += 512) { const int r = e >> 5, k8 = (e & 31) * 8; u32x4 w = (u32x4){0u, 0u, 0u, 0u};
            if (r < NCROW) { const float* cp = (r < 2 ? IN(5) + (size_t)r * DM : IN(6) + (size_t)(r - 2) * DM) + kc * 256 + k8;
                const f32x4 a = *(const f32x4*)cp, b = *(const f32x4*)(cp + 4);
                w.x = pk2(silu2(a.x), silu2(a.y)); w.y = pk2(silu2(a.z), silu2(a.w)); w.z = pk2(silu2(b.x), silu2(b.y)); w.w = pk2(silu2(b.z), silu2(b.w)); }
            *(LAS u32x4*)(As + r * 264 + k8) = w; }
        __syncthreads();
        const float* Wk = W + (size_t)(kc * 256 + fq * 8) * MODW;
#pragma unroll 4
        for (int ks = 0; ks < 8; ++ks) {
            float bv[8];
#pragma unroll
            for (int j = 0; j < 8; ++j) bv[j] = Wk[(size_t)(ks * 32 + j) * MODW];
            const bf16x8 bf = __builtin_bit_cast(bf16x8, pack8(bv));
#pragma unroll
            for (int mt = 0; mt < 9; ++mt) { const bf16x8 av = *(const LAS bf16x8*)(As + (mt * 16 + fr) * 264 + ks * 32 + fq * 8);
                acc[mt] = __builtin_amdgcn_mfma_f32_16x16x32_bf16(av, bf, acc[mt], 0, 0, 0); }
        }
    }
    const float bias = IN(21)[l * MODW + n0 + fr];
    float* mo = WSP(float, WS_MOD) + (size_t)l * NCROW * MODW + n0 + fr;
#pragma unroll
    for (int mt = 0; mt < 9; ++mt)
#pragma unroll
        for (int i = 0; i < 4; ++i) { const int r = mt * 16 + fq * 4 + i; if (r < NCROW) mo[(size_t)r * MODW] = acc[mt][i] + bias; }
}
__device__ __forceinline__ void phase_prologue(const Ctx& C, int rep = 0) {
    {
        float* rt = WSP(float, WS_ROPE);
        for (int e = C.bid * 512 + C.tid; e < 8193 * 8; e += C.G * 512) {
            const int p = e >> 3, i = e & 7; const int pos = (p == 8192) ? 16384 : p;
            const float invf = exp2f(-(float)i * 2.3664460711655217f);
            const double rev = (double)pos * (double)invf * 0.15915494309189535;
            const float r = (float)((rev - rint(rev)) * 6.283185307179586);
            rt[p * 16 + i] = __cosf(r); rt[p * 16 + 8 + i] = __sinf(r);
        }
    }
    unsigned* ctr = WSP(unsigned, 0) + rep * 64;
    volatile LAS int* sitem = (volatile LAS int*)(C.lds + LDS_BYTES - 16);
    for (;;) {
        __syncthreads();
        if (C.tid == 0) *sitem = (int)atomicAdd(ctr, 1u);
        __syncthreads();
        const int it = *sitem;
        if (it >= 144 + 2 * (N_TR_LAYER / 8)) break;
        if (it < 144) ada_item(C, it); else { const int q = it - 144; transpose_dispatch(C, q / (N_TR_LAYER / 8), (q % (N_TR_LAYER / 8)) * 8 + C.wave); }
    }
}

__device__ __forceinline__ void phase_mod0(const Ctx& C) {
    const int gw = C.bid * 8 + C.wave, NGW = C.G * 8;
    const float* mod = WSP(float, WS_MOD);
#define ROWSRC(r) ((r) < MP ? IN(0) + (size_t)(r) * DM : IN(1) + (size_t)((r) - MP) * DM)
    f32x4 nx[4];
    if (gw < MR) { const float* xs = ROWSRC(gw);
#pragma unroll
        for (int j = 0; j < 4; ++j) nx[j] = *(const f32x4*)(xs + 4 * C.lane + 256 * j); }
    for (int r = gw; r < MR; r += NGW) {
        f32x4 x[4];
#pragma unroll
        for (int j = 0; j < 4; ++j) x[j] = nx[j];
        const int rn = r + NGW;
        if (rn < MR) { const float* xs = ROWSRC(rn);
#pragma unroll
            for (int j = 0; j < 4; ++j) nx[j] = *(const f32x4*)(xs + 4 * C.lane + 256 * j); }
        const float* mp = mod + (size_t)crow_of(r) * MODW;
        bf16_t* ho = WSP(bf16_t, WS_H) + (size_t)r * DM;
#pragma unroll
        for (int j = 0; j < 4; ++j) { const int c = 4 * C.lane + 256 * j;
            const f32x4 sh = *(const f32x4*)(mp + c), sc = *(const f32x4*)(mp + DM + c);
            const f32x4 h = x[j] * (sc + 1.0f) + sh;
            u32x2 w; w.x = pk2(h.x, h.y); w.y = pk2(h.z, h.w); *(u32x2*)(ho + c) = w; }
    }
#undef ROWSRC
}

__device__ __forceinline__ void ln_finish(const Ctx& C, int r, float (&v)[2][8], const f32x4 (&gv)[2][2], const f32x4 (&bv)[2][2], const float* mp, bool last, float* ST) {
    float s = 0.f;
#pragma unroll
    for (int j = 0; j < 2; ++j)
#pragma unroll
        for (int e = 0; e < 8; ++e) s += v[j][e];
    const float mean = wave_sum(s) * (1.0f / DM); float s2 = 0.f;
#pragma unroll
    for (int j = 0; j < 2; ++j)
#pragma unroll
        for (int e = 0; e < 8; ++e) { v[j][e] -= mean; s2 += v[j][e] * v[j][e]; }
    const float rstd = 1.0f / sqrtf(wave_sum(s2) * (1.0f / DM) + 1e-5f);
    if (!last && C.lane == 0) { ST[2 * r] = mean; ST[2 * r + 1] = rstd; }
#pragma unroll
    for (int j = 0; j < 2; ++j) { const int c = 8 * C.lane + 512 * j;
        float y[8];
#pragma unroll
        for (int e = 0; e < 8; ++e) y[e] = v[j][e] * rstd * gv[j][e >> 2][e & 3] + bv[j][e >> 2][e & 3];
        if (last) { float* yo = C.out + (size_t)r * DM + c; *(f32x4*)yo = (f32x4){y[0], y[1], y[2], y[3]}; *(f32x4*)(yo + 4) = (f32x4){y[4], y[5], y[6], y[7]}; }
        else { const f32x4 sh0 = *(const f32x4*)(mp + c), sh1 = *(const f32x4*)(mp + c + 4), sc0 = *(const f32x4*)(mp + DM + c), sc1 = *(const f32x4*)(mp + DM + c + 4);
            float h[8];
#pragma unroll
            for (int e = 0; e < 8; ++e) h[e] = y[e] * ((e < 4 ? sc0[e & 3] : sc1[e & 3]) + 1.0f) + (e < 4 ? sh0[e & 3] : sh1[e & 3]);
            *(u32x4*)(WSP(bf16_t, WS_H) + (size_t)r * DM + c) = pack8(h); }
    }
}
__device__ __forceinline__ void phase_ln(const Ctx& C, int l, int which, int rep = 0) {
    const int gw = C.bid * 8 + C.wave, NGW = C.G * 8;
    const int li = l * 3 + which;
    const float* g = IN(22) + (size_t)li * DM; const float* bb = IN(23) + (size_t)li * DM;
    const bool has_prev = (li > 0), last = (li == 3 * DEPTH - 1);
    const float* pg = IN(22) + (size_t)(has_prev ? li - 1 : 0) * DM; const float* pb = IN(23) + (size_t)(has_prev ? li - 1 : 0) * DM;
    int ml = l, si = (which == 0) ? 3 : 6;
    if (which == 2) { ml = l + 1; si = 0; }
    const float* mod = WSP(float, WS_MOD) + (size_t)(last ? 0 : ml) * NCROW * MODW + (size_t)si * DM;
    const float* gatep = WSP(float, WS_MOD) + (size_t)l * NCROW * MODW + (size_t)(which == 0 ? 2 : which == 1 ? 5 : 8) * DM;
    const float rscale = (which == 1) ? 1.0f : 0.5f;
    float* ST = WSP(float, WS_ST);
    bf16_t* XB = WSP(bf16_t, WS_XB);
    f32x4 gv[2][2], bv[2][2];
#pragma unroll
    for (int j = 0; j < 2; ++j)
#pragma unroll
        for (int q = 0; q < 2; ++q) { gv[j][q] = *(const f32x4*)(g + 8 * C.lane + 512 * j + 4 * q); bv[j][q] = *(const f32x4*)(bb + 8 * C.lane + 512 * j + 4 * q); }
    {
        u32x4 nv[2];
        if (gw < MP) { nv[0] = *(const u32x4*)(XB + (size_t)gw * DM + 8 * C.lane); nv[1] = *(const u32x4*)(XB + (size_t)gw * DM + 8 * C.lane + 512); }
        for (int r = gw; r < MP; r += NGW) {
            float v[2][8]; unpack8(nv[0], v[0]); unpack8(nv[1], v[1]);
            const int rn = r + NGW;
            if (rn < MP) { nv[0] = *(const u32x4*)(XB + (size_t)rn * DM + 8 * C.lane); nv[1] = *(const u32x4*)(XB + (size_t)rn * DM + 8 * C.lane + 512); }
            ln_finish(C, r, v, gv, bv, mod + (size_t)(r >> 13) * MODW, last, ST);
        }
    }
    for (int r = MP + gw; r < MR && rep == 0; r += NGW) {
        float v[2][8];
        float pm = 0.f, pr = 1.f; if (has_prev) { pm = ST[2 * r]; pr = ST[2 * r + 1]; }
        const float* ys = WSP(float, WS_YS) + (size_t)(r - MP) * DM; const float* gp = gatep + (size_t)crow_of(r) * MODW;
#pragma unroll
        for (int j = 0; j < 2; ++j) { const int c = 8 * C.lane + 512 * j;
            float x[8];
            if (has_prev) { unpack8(*(const u32x4*)(XB + (size_t)r * DM + c), x);
#pragma unroll
                for (int e = 0; e < 8; ++e) x[e] = (x[e] - pm) * pr * pg[c + e] + pb[c + e]; }
            else { const float* xs = IN(1) + (size_t)(r - MP) * DM + c;
#pragma unroll
                for (int e = 0; e < 8; ++e) x[e] = xs[e]; }
#pragma unroll
            for (int e = 0; e < 8; ++e) { const float y = (ys[c + e] + ys[131072 + c + e]) + (ys[262144 + c + e] + ys[393216 + c + e]);
                v[j][e] = x[e] * ALPHA_F + (gp[c + e] + 1.0f) * (y * rscale); }
            if (!last) { const u32x4 w = pack8(v[j]); *(u32x4*)(XB + (size_t)r * DM + c) = w; unpack8(w, v[j]); }
        }
        ln_finish(C, r, v, gv, bv, mod + (size_t)crow_of(r) * MODW, last, ST);
    }
}

__device__ __forceinline__ int vperm(int key) { return (key & ~31) | (((key >> 2) & 3) << 3) | (((key >> 4) & 1) << 2) | (key & 3); }
__device__ __forceinline__ void attn_prompt_item(const Ctx& C, int l, int item) {
    const int b = item >> 7, blk = (item >> 1) & 63, kvh = item & 1;
    LAS bf16_t* Ks = (LAS bf16_t*)C.lds;
    LAS bf16_t* Vt = (LAS bf16_t*)(C.lds + 36864);
    const bf16_t* P = WSP(bf16_t, WS_PROJ) + (size_t)b * SEQ * DIN;
    const float* rope = WSP(float, WS_ROPE);
    u32x4 qpre0[4], qpre1[4]; f32x4 rcs[4][4];
    {   const int fr_ = C.lane & 15, fq_ = C.lane >> 4, hq_ = kvh * 4 + (C.wave >> 1);
#pragma unroll
        for (int st = 0; st < 4; ++st) { const int t_ = blk * 128 + ((C.wave & 1) * 4 + st) * 16 + fr_; const bf16_t* qp = P + (size_t)t_ * DIN + hq_ * 64;
            qpre0[st] = *(const u32x4*)(qp + fq_ * 8); qpre1[st] = *(const u32x4*)(qp + 32 + fq_ * 8);
            const float* rr = rope + (size_t)t_ * 16; rcs[st][0] = *(const f32x4*)rr; rcs[st][1] = *(const f32x4*)(rr + 4); rcs[st][2] = *(const f32x4*)(rr + 8); rcs[st][3] = *(const f32x4*)(rr + 12); } }
    __syncthreads();
    {
        const int seg = C.tid & 7, key0 = C.tid >> 3;
#pragma unroll 1
        for (int hb = 0; hb < 2; ++hb) {
            u32x4 kwv[2], vwv[2], owv[2]; f32x4 rc[2][4];
#pragma unroll
            for (int j = 0; j < 2; ++j) { const int key = key0 + 64 * (2 * hb + j), t = (blk - 1) * 128 + key;
                kwv[j] = (u32x4){0u, 0u, 0u, 0u}; vwv[j] = kwv[j]; owv[j] = kwv[j];
#pragma unroll
                for (int q = 0; q < 4; ++q) rc[j][q] = (f32x4){0.f, 0.f, 0.f, 0.f};
                if (t >= 0) { const bf16_t* rp = P + (size_t)t * DIN;
                    kwv[j] = *(const u32x4*)(rp + 512 + kvh * 64 + seg * 8); vwv[j] = *(const u32x4*)(rp + 640 + kvh * 64 + seg * 8);
                    if (seg < 2) { owv[j] = *(const u32x4*)(rp + 512 + kvh * 64 + (seg ^ 1) * 8); const float* rr = rope + (size_t)t * 16;
                        rc[j][0] = *(const f32x4*)rr; rc[j][1] = *(const f32x4*)(rr + 4); rc[j][2] = *(const f32x4*)(rr + 8); rc[j][3] = *(const f32x4*)(rr + 12); } } }
#pragma unroll
            for (int j = 0; j < 2; ++j) { const int key = key0 + 64 * (2 * hb + j);
                u32x4 kw = kwv[j]; float kf[8], vf[8];
                if (seg < 2) { float of[8]; unpack8(kw, kf); unpack8(owv[j], of);
#pragma unroll
                    for (int e = 0; e < 8; ++e) { const float cs = rc[j][e >> 2][e & 3], sn = rc[j][2 + (e >> 2)][e & 3]; kf[e] = (seg == 0) ? (kf[e] * cs - of[e] * sn) : (kf[e] * cs + of[e] * sn); }
                    kw = pack8(kf); }
                *(LAS u32x4*)(Ks + key * 72 + seg * 8) = kw;
                unpack8(vwv[j], vf);
                const int pk = vperm(key);
#pragma unroll
                for (int e = 0; e < 8; ++e) Vt[(seg * 8 + e) * 264 + pk] = (bf16_t)(__float_as_uint(vf[e]) >> 16);
                if (blk == 63 && key >= 128) {
                    unpack8(kw, kf);
                    const size_t o = ((size_t)((l * 2 + b) * 128 + (key - 128)) * 2 + kvh) * 64 + seg * 8;
                    *(f32x4*)(C.out + O_KWIN + o) = (f32x4){kf[0], kf[1], kf[2], kf[3]}; *(f32x4*)(C.out + O_KWIN + o + 4) = (f32x4){kf[4], kf[5], kf[6], kf[7]};
                    *(f32x4*)(C.out + O_VWIN + o) = (f32x4){vf[0], vf[1], vf[2], vf[3]}; *(f32x4*)(C.out + O_VWIN + o + 4) = (f32x4){vf[4], vf[5], vf[6], vf[7]};
                }
            }
        }
    }
    __syncthreads();
    const int w = C.wave, lane = C.lane, fr = lane & 15, fq = lane >> 4;
    const int hq = kvh * 4 + (w >> 1);
    const float sink = IN(9)[l * 8 + hq];
    bf16_t* MIX = WSP(bf16_t, WS_MIX) + (size_t)b * SEQ * DM;
#pragma unroll
    for (int st = 0; st < 4; ++st) {
        const int isub = (w & 1) * 4 + st; const int t = blk * 128 + isub * 16 + fr;
        u32x4 q0w = qpre0[st]; const u32x4 q1w = qpre1[st];
        {
            float x[8], o[8]; unpack8(q0w, x);
#pragma unroll
            for (int e = 0; e < 8; ++e) o[e] = __shfl_xor(x[e], 16);
            if (fq < 2) {
#pragma unroll
                for (int e = 0; e < 8; ++e) { const float cs = rcs[st][e >> 2][e & 3], sn = rcs[st][2 + (e >> 2)][e & 3]; x[e] = (fq == 0) ? (x[e] * cs - o[e] * sn) : (x[e] * cs + o[e] * sn); }
                q0w = pack8(x);
            }
        }
        const bf16x8 q0 = __builtin_bit_cast(bf16x8, q0w), q1 = __builtin_bit_cast(bf16x8, q1w);
        const int kbase = 32 * (isub >> 1);
        f32x4 s[10];
#pragma unroll
        for (int j = 0; j < 10; ++j) {
            const LAS bf16_t* kp = Ks + (kbase + 16 * j + fr) * 72 + fq * 8;
            const bf16x8 a0 = *(const LAS bf16x8*)kp, a1 = *(const LAS bf16x8*)(kp + 32);
            f32x4 z = (f32x4){0.f, 0.f, 0.f, 0.f};
            z = __builtin_amdgcn_mfma_f32_16x16x32_bf16(a0, q0, z, 0, 0, 0);
            s[j] = __builtin_amdgcn_mfma_f32_16x16x32_bf16(a1, q1, z, 0, 0, 0);
        }
        const int qi = 128 + isub * 16 + fr;
        float mx = sink;
#pragma unroll
        for (int j = 0; j < 10; ++j)
#pragma unroll
            for (int i = 0; i < 4; ++i) { const int kj = kbase + 16 * j + 4 * fq + i;
                const bool valid = (kj <= qi) && (qi - kj < 128) && (blk > 0 || kj >= 128);
                const float v = valid ? s[j][i] * 0.125f : -1e30f; s[j][i] = v; mx = fmaxf(mx, v); }
        mx = fmaxf(mx, __shfl_xor(mx, 16)); mx = fmaxf(mx, __shfl_xor(mx, 32));
        float sum = 0.f;
#pragma unroll
        for (int j = 0; j < 10; ++j)
#pragma unroll
            for (int i = 0; i < 4; ++i) { const float p = __expf(s[j][i] - mx); s[j][i] = p; sum += p; }
        sum += __shfl_xor(sum, 16); sum += __shfl_xor(sum, 32); sum += __expf(sink - mx);
        const float rl = 1.0f / sum;
        f32x4 o[4];
#pragma unroll
        for (int dt = 0; dt < 4; ++dt) o[dt] = (f32x4){0.f, 0.f, 0.f, 0.f};
#pragma unroll
        for (int g = 0; g < 5; ++g) {
            u32x4 pw; pw.x = pk2(s[2 * g][0], s[2 * g][1]); pw.y = pk2(s[2 * g][2], s[2 * g][3]); pw.z = pk2(s[2 * g + 1][0], s[2 * g + 1][1]); pw.w = pk2(s[2 * g + 1][2], s[2 * g + 1][3]);
            const bf16x8 pb = __builtin_bit_cast(bf16x8, pw);
#pragma unroll
            for (int dt = 0; dt < 4; ++dt) {
                const bf16x8 av = *(const LAS bf16x8*)(Vt + (dt * 16 + fr) * 264 + kbase + 32 * g + fq * 8);
                o[dt] = __builtin_amdgcn_mfma_f32_16x16x32_bf16(av, pb, o[dt], 0, 0, 0);
            }
        }
        bf16_t* op = MIX + (size_t)t * DM + hq * 64 + 4 * fq;
#pragma unroll
        for (int dt = 0; dt < 4; ++dt) { u32x2 wv; wv.x = pk2(o[dt][0] * rl, o[dt][1] * rl); wv.y = pk2(o[dt][2] * rl, o[dt][3] * rl); *(u32x2*)(op + dt * 16) = wv; }
    }
}

__device__ __forceinline__ float hgrn_lb(const Ctx& C, int l, int j) { return l == 0 ? 0.f : sigmoid_f(IN(14)[256 + j] - IN(14)[j]); }
typedef float f32x2 __attribute__((ext_vector_type(2)));
#define LDS_BARRIER() asm volatile("s_waitcnt lgkmcnt(0)\n\ts_barrier" ::: "memory")
__device__ __forceinline__ void hgrn_local_item(const Ctx& C, int l, int pair, int xmode = 0) {
    const int hi = C.tid >> 8, tl = C.tid & 255, wl = (C.tid >> 6) & 3;
    const int chain = pair >> 5, chunk = (pair & 31) * 2 + hi, b = chain >> 2, h = chain & 3, t0 = chunk * 128;
    LAS float* base = (LAS float*)C.lds + hi * 12288;
    LAS float* Fs = base; LAS float* Qt = base + 1024; LAS float* Is = base + 2048; LAS float* Qs = base + 3072; LAS float* Ob = base + 4096;
    const int lane = C.lane, kg = lane >> 3, vp = lane & 7, v0 = 16 * wl + 2 * vp;
    float* HS = WSP(float, WS_HGS) + (size_t)(chain * 64 + chunk) * 4096;
    f32x2 Sa[4], Sb2[4], D2[4];
#pragma unroll
    for (int j = 0; j < 4; ++j) { Sa[j] = (f32x2){0.f, 0.f}; Sb2[j] = (f32x2){0.f, 0.f}; D2[j] = (f32x2){1.f, 1.f}; }
    const int tt = tl >> 4, c4 = (tl & 15) * 4;
    f32x4 lbv;
    lbv.x = hgrn_lb(C, l, h * 64 + c4); lbv.y = hgrn_lb(C, l, h * 64 + c4 + 1); lbv.z = hgrn_lb(C, l, h * 64 + c4 + 2); lbv.w = hgrn_lb(C, l, h * 64 + c4 + 3);
    const bf16_t* P = WSP(bf16_t, WS_PROJ) + (size_t)(b * SEQ + t0) * DIN + h * 64 + c4;
    const bool qwriter = (wl == 0 && vp == 0);
    u32x2 pf, pi, pq;
    { const bf16_t* rp = P + (size_t)tt * DIN; pf = *(const u32x2*)(rp + 1536); pi = *(const u32x2*)(rp + 1792); pq = *(const u32x2*)(rp + 1280); }
#define HG_FLUSH(sub_) do { const size_t row = (size_t)(b * SEQ + t0 + (sub_) * 16 + tt); float o0 = 0.f, o1 = 0.f, o2 = 0.f, o3 = 0.f; \
        const LAS float* p0 = Ob + tt * 512 + c4 * 8; \
        _Pragma("unroll") for (int i = 0; i < 8; ++i) { const int c = (i + tl) & 7; const f32x4 pv = *(const LAS f32x4*)(p0 + c * 4); const float sv = (pv.x + pv.y) + (pv.z + pv.w); const int e = c >> 1; \
            o0 += (e == 0) ? sv : 0.f; o1 += (e == 1) ? sv : 0.f; o2 += (e == 2) ? sv : 0.f; o3 += (e == 3) ? sv : 0.f; } \
        *(f32x4*)(WSP(float, WS_OL) + row * 256 + h * 64 + c4) = (f32x4){o0, o1, o2, o3}; \
        const f32x4 qd = *(const LAS f32x4*)(Qt + tt * 64 + c4); u32x2 qw; qw.x = pk2(qd.x, qd.y); qw.y = pk2(qd.z, qd.w); \
        *(u32x2*)(WSP(bf16_t, WS_QT) + row * 256 + h * 64 + c4) = qw; } while (0)
#pragma unroll 1
    for (int sub = 0; sub < 8; ++sub) {
        LDS_BARRIER();
        const u32x2 cpf = pf, cpi = pi, cpq = pq;
        if (sub < 7) { const bf16_t* rp = P + (size_t)((sub + 1) * 16 + tt) * DIN; pf = *(const u32x2*)(rp + 1536); pi = *(const u32x2*)(rp + 1792); pq = *(const u32x2*)(rp + 1280); }
        if (sub > 0 && xmode == 0) HG_FLUSH(sub - 1);
        {
            const float cf[4] = {bf2f(cpf.x & 0xffffu), bf2f(cpf.x >> 16), bf2f(cpf.y & 0xffffu), bf2f(cpf.y >> 16)};
            f32x4 f;
            f.x = lbv.x + (1.0f - lbv.x) * __builtin_amdgcn_rcpf(1.0f + __expf(-cf[0])); f.y = lbv.y + (1.0f - lbv.y) * __builtin_amdgcn_rcpf(1.0f + __expf(-cf[1]));
            f.z = lbv.z + (1.0f - lbv.z) * __builtin_amdgcn_rcpf(1.0f + __expf(-cf[2])); f.w = lbv.w + (1.0f - lbv.w) * __builtin_amdgcn_rcpf(1.0f + __expf(-cf[3]));
            *(LAS f32x4*)(Fs + tt * 64 + c4) = f;
            *(LAS f32x4*)(Is + tt * 64 + c4) = (f32x4){bf2f(cpi.x & 0xffffu), bf2f(cpi.x >> 16), bf2f(cpi.y & 0xffffu), bf2f(cpi.y >> 16)};
            *(LAS f32x4*)(Qs + tt * 64 + c4) = (f32x4){bf2f(cpq.x & 0xffffu), bf2f(cpq.x >> 16), bf2f(cpq.y & 0xffffu), bf2f(cpq.y >> 16)};
        }
        LDS_BARRIER();
        if (xmode != 2) {
            const LAS float* fp = Fs + kg * 8; const LAS float* ip = Is + v0; const LAS float* qp = Qs + kg * 8; LAS float* op = Ob + v0 * 8 + kg; LAS float* qtp = Qt + kg * 8;
            f32x4 fa_n = *(const LAS f32x4*)fp, fb_n = *(const LAS f32x4*)(fp + 4), qa_n = *(const LAS f32x4*)qp, qb_n = *(const LAS f32x4*)(qp + 4); f32x2 iv_n = *(const LAS f32x2*)ip;
#pragma unroll
            for (int t = 0; t < 16; ++t) {
                const f32x4 fa = fa_n, fb = fb_n, qa = qa_n, qb = qb_n; const f32x2 ivv = iv_n;
                if (t < 15) { fa_n = *(const LAS f32x4*)(fp + (t + 1) * 64); fb_n = *(const LAS f32x4*)(fp + (t + 1) * 64 + 4); iv_n = *(const LAS f32x2*)(ip + (t + 1) * 64);
                    qa_n = *(const LAS f32x4*)(qp + (t + 1) * 64); qb_n = *(const LAS f32x4*)(qp + (t + 1) * 64 + 4); }
                const f32x2 ia = (f32x2){ivv.x, ivv.x}, ib = (f32x2){ivv.y, ivv.y};
                Sa[0] = ia + fa.xy * (Sa[0] - ia); Sa[1] = ia + fa.zw * (Sa[1] - ia); Sa[2] = ia + fb.xy * (Sa[2] - ia); Sa[3] = ia + fb.zw * (Sa[3] - ia);
                Sb2[0] = ib + fa.xy * (Sb2[0] - ib); Sb2[1] = ib + fa.zw * (Sb2[1] - ib); Sb2[2] = ib + fb.xy * (Sb2[2] - ib); Sb2[3] = ib + fb.zw * (Sb2[3] - ib);
                D2[0] *= fa.xy; D2[1] *= fa.zw; D2[2] *= fb.xy; D2[3] *= fb.zw;
                const f32x2 oa = qa.xy * Sa[0] + qa.zw * Sa[1] + qb.xy * Sa[2] + qb.zw * Sa[3];
                const f32x2 ob = qa.xy * Sb2[0] + qa.zw * Sb2[1] + qb.xy * Sb2[2] + qb.zw * Sb2[3];
                op[t * 512] = oa.x + oa.y; op[t * 512 + 8] = ob.x + ob.y;
                if (qwriter) { const f32x2 q0 = qa.xy * D2[0], q1 = qa.zw * D2[1], q2 = qb.xy * D2[2], q3 = qb.zw * D2[3];
                    *(LAS f32x4*)(qtp + t * 64) = (f32x4){q0.x, q0.y, q1.x, q1.y}; *(LAS f32x4*)(qtp + t * 64 + 4) = (f32x4){q2.x, q2.y, q3.x, q3.y}; }
            }
        }
    }
    LDS_BARRIER();
    if (xmode == 0) HG_FLUSH(7);
#undef HG_FLUSH
    if (xmode != 0) return;
#pragma unroll
    for (int j = 0; j < 4; ++j) { float* p0 = HS + (kg * 8 + 2 * j) * 64 + v0; *(f32x2*)p0 = (f32x2){Sa[j].x, Sb2[j].x}; *(f32x2*)(p0 + 64) = (f32x2){Sa[j].y, Sb2[j].y}; }
    if (qwriter) {
        float* HD = WSP(float, WS_HGD) + (size_t)(chain * 64 + chunk) * 64 + kg * 8;
#pragma unroll
        for (int j = 0; j < 4; ++j) { HD[2 * j] = D2[j].x; HD[2 * j + 1] = D2[j].y; }
    }
}
__device__ __forceinline__ void hgrn_corr_item(const Ctx& C, int l, int pair) {
    const int hi = C.tid >> 8, tl = C.tid & 255, wl = (C.tid >> 6) & 3;
    const int chain = pair >> 5, chunk = (pair & 31) * 2 + hi, b = chain >> 2, h = chain & 3, t0 = chunk * 128;
    LAS bf16_t* Sb = (LAS bf16_t*)C.lds + hi * (64 * 72);
    const float* HS = WSP(float, WS_HGS) + (size_t)(chain * 64 + chunk) * 4096;
    const int lane = C.lane, fr = lane & 15, fq = lane >> 4;
    const size_t row0 = (size_t)(b * SEQ + t0 + wl * 32);
    u32x4 qa[2][2];
#pragma unroll
    for (int mt = 0; mt < 2; ++mt)
#pragma unroll
        for (int ks = 0; ks < 2; ++ks) qa[mt][ks] = *(const u32x4*)(WSP(bf16_t, WS_QT) + (row0 + mt * 16 + fr) * 256 + h * 64 + ks * 32 + fq * 8);
    __syncthreads();
    if (chunk > 0) {
        const int k = tl >> 2, vb = (tl & 3) * 16;
#pragma unroll
        for (int q = 0; q < 4; ++q) { const f32x4 sv = *(const f32x4*)(HS + k * 64 + vb + 4 * q);
            Sb[(vb + 4 * q) * 72 + k] = (bf16_t)f2bf(sv.x); Sb[(vb + 4 * q + 1) * 72 + k] = (bf16_t)f2bf(sv.y); Sb[(vb + 4 * q + 2) * 72 + k] = (bf16_t)f2bf(sv.z); Sb[(vb + 4 * q + 3) * 72 + k] = (bf16_t)f2bf(sv.w); }
    }
    __syncthreads();
    f32x4 acc[2][4];
#pragma unroll
    for (int mt = 0; mt < 2; ++mt)
#pragma unroll
        for (int nt = 0; nt < 4; ++nt) acc[mt][nt] = (f32x4){0.f, 0.f, 0.f, 0.f};
    if (chunk > 0) {
#pragma unroll
        for (int nt = 0; nt < 4; ++nt)
#pragma unroll
            for (int ks = 0; ks < 2; ++ks) { const bf16x8 bv = *(const LAS bf16x8*)(Sb + (nt * 16 + fr) * 72 + ks * 32 + fq * 8);
#pragma unroll
                for (int mt = 0; mt < 2; ++mt) acc[mt][nt] = __builtin_amdgcn_mfma_f32_16x16x32_bf16(__builtin_bit_cast(bf16x8, qa[mt][ks]), bv, acc[mt][nt], 0, 0, 0); }
    }
    float gnv[4];
#pragma unroll
    for (int nt = 0; nt < 4; ++nt) gnv[nt] = IN(15)[l * 64 + nt * 16 + fr];
#pragma unroll
    for (int mt = 0; mt < 2; ++mt) {
        float ol[4][4], cg[4][4];
#pragma unroll
        for (int i = 0; i < 4; ++i) { const size_t row = row0 + mt * 16 + fq * 4 + i;
#pragma unroll
            for (int nt = 0; nt < 4; ++nt) { ol[i][nt] = WSP(float, WS_OL)[row * 256 + h * 64 + nt * 16 + fr]; cg[i][nt] = bf2f(WSP(bf16_t, WS_PROJ)[row * DIN + 2048 + h * 64 + nt * 16 + fr]); } }
#pragma unroll
        for (int i = 0; i < 4; ++i) { const size_t row = row0 + mt * 16 + fq * 4 + i;
            float o[4], ss = 0.f;
#pragma unroll
            for (int nt = 0; nt < 4; ++nt) { o[nt] = acc[mt][nt][i] + ol[i][nt]; ss += o[nt] * o[nt]; }
            ss += __shfl_xor(ss, 1); ss += __shfl_xor(ss, 2); ss += __shfl_xor(ss, 4); ss += __shfl_xor(ss, 8);
            const float r = __builtin_amdgcn_rsqf(ss * (1.0f / 64.0f) + 1e-6f);
            bf16_t* op = WSP(bf16_t, WS_MIX) + row * DM + 768 + h * 64 + fr;
#pragma unroll
            for (int nt = 0; nt < 4; ++nt) op[nt * 16] = (bf16_t)f2bf(o[nt] * r * gnv[nt] * silu2(cg[i][nt])); }
    }
}
__device__ __forceinline__ void hgrn_scan(const Ctx& C, int l) {
    for (int gid = C.bid * 512 + C.tid; gid < 131072; gid += C.G * 512) {
        const int e = gid >> 2, j = gid & 3, chain = e >> 12, kv = e & 4095, k = kv >> 6;
        float* hs = WSP(float, WS_HGS) + ((size_t)chain * 64 + 16 * j) * 4096 + kv; const float* hd = WSP(float, WS_HGD) + ((size_t)chain * 64 + 16 * j) * 64 + k;
        float vv[16], dd[16];
#pragma unroll
        for (int i = 0; i < 16; ++i) { vv[i] = hs[(size_t)i * 4096]; dd[i] = hd[i * 64]; }
        float A = 1.f, B = 0.f;
#pragma unroll
        for (int i = 0; i < 16; ++i) { B = dd[i] * B + vv[i]; A *= dd[i]; }
        float S = 0.f;
#pragma unroll
        for (int m = 0; m < 3; ++m) { const float Am = __shfl(A, (C.lane & ~3) + m), Bm = __shfl(B, (C.lane & ~3) + m); if (m < j) S = Am * S + Bm; }
#pragma unroll
        for (int i = 0; i < 16; ++i) { hs[(size_t)i * 4096] = S; S = dd[i] * S + vv[i]; }
        if (j == 3) C.out[O_HSP + (size_t)(l * 8 + chain) * 4096 + kv] = S;
    }
}

__device__ __forceinline__ void gmlp_prompt_item(const Ctx& C, int l, int item) {
    const int b = item >> 8, n = (item >> 2) & 63, g = item & 3;
    LAS bf16_t* Wb = (LAS bf16_t*)C.lds;
    LAS bf16_t* VnT = Wb + 128 * 136;
    __syncthreads();
    const float* Wg = IN(12) + (size_t)(l * 4 + g) * 128 * 128;
    const bf16_t* P = WSP(bf16_t, WS_PROJ) + (size_t)(b * SEQ + n * 128) * DIN;
    {
        f32x4 wa[4], wb[4];
#pragma unroll
        for (int i = 0; i < 4; ++i) { const int e = C.tid + 512 * i, t = e >> 4, s8 = (e & 15) * 8; wa[i] = *(const f32x4*)(Wg + t * 128 + s8); wb[i] = *(const f32x4*)(Wg + t * 128 + s8 + 4); }
        const int s = C.tid >> 2, q4 = C.tid & 3;
        const bf16_t* gp = P + (size_t)s * DIN + 1024 + q4 * 64;
        u32x4 xr[8];
#pragma unroll
        for (int i = 0; i < 8; ++i) xr[i] = *(const u32x4*)(gp + i * 8);
        const bf16_t* gg = P + (size_t)s * DIN + 1024 + g * 64 + q4 * 16;
        const u32x4 y0 = *(const u32x4*)gg, y1 = *(const u32x4*)(gg + 8);
        f32x4 lgv[4], lbv4[4];
#pragma unroll
        for (int i = 0; i < 4; ++i) { lgv[i] = *(const f32x4*)(IN(10) + l * 256 + g * 64 + q4 * 16 + 4 * i); lbv4[i] = *(const f32x4*)(IN(11) + l * 256 + g * 64 + q4 * 16 + 4 * i); }
#pragma unroll
        for (int i = 0; i < 4; ++i) { const int e = C.tid + 512 * i, t = e >> 4, s8 = (e & 15) * 8;
            float w[8] = {wa[i].x, wa[i].y, wa[i].z, wa[i].w, wb[i].x, wb[i].y, wb[i].z, wb[i].w};
#pragma unroll
            for (int j = 0; j < 8; ++j) if (s8 + j > t) w[j] = 0.f;
            *(LAS u32x4*)(Wb + t * 136 + s8) = pack8(w); }
        float sm = 0.f, sq = 0.f;
#pragma unroll
        for (int i = 0; i < 8; ++i) { float x[8]; unpack8(xr[i], x);
#pragma unroll
            for (int e = 0; e < 8; ++e) { sm += x[e]; sq += x[e] * x[e]; } }
        sm += __shfl_xor(sm, 1); sm += __shfl_xor(sm, 2); sq += __shfl_xor(sq, 1); sq += __shfl_xor(sq, 2);
        const float mean = sm * (1.0f / 256.0f);
        const float var = fmaxf(sq * (1.0f / 256.0f) - mean * mean, 0.f);
        const float rstd = 1.0f / sqrtf(var + 1e-5f);
        float x[16]; unpack8(y0, x); unpack8(y1, x + 8);
#pragma unroll
        for (int i = 0; i < 16; ++i) VnT[(q4 * 16 + i) * 136 + s] = (bf16_t)f2bf((x[i] - mean) * rstd * lgv[i >> 2][i & 3] + lbv4[i >> 2][i & 3]);
    }
    __syncthreads();
    {
        const int w = C.wave, lane = C.lane, fr = lane & 15, fq = lane >> 4;
        f32x4 acc[4];
#pragma unroll
        for (int ct = 0; ct < 4; ++ct) acc[ct] = (f32x4){0.f, 0.f, 0.f, 0.f};
        const float* bsp = IN(13) + (l * 4 + g) * 128 + w * 16 + fq * 4;
        const f32x4 bias4 = *(const f32x4*)bsp;
        bf16_t uu[4][4];
#pragma unroll
        for (int i = 0; i < 4; ++i)
#pragma unroll
            for (int ct = 0; ct < 4; ++ct) uu[i][ct] = P[(size_t)(w * 16 + fq * 4 + i) * DIN + 768 + g * 64 + fr + ct * 16];
        const int nks = (w >> 1) + 1;
        for (int ks = 0; ks < nks; ++ks) {
            const bf16x8 av = *(const LAS bf16x8*)(Wb + (w * 16 + fr) * 136 + ks * 32 + fq * 8);
#pragma unroll
            for (int ct = 0; ct < 4; ++ct) { const bf16x8 bv = *(const LAS bf16x8*)(VnT + (ct * 16 + fr) * 136 + ks * 32 + fq * 8);
                acc[ct] = __builtin_amdgcn_mfma_f32_16x16x32_bf16(av, bv, acc[ct], 0, 0, 0); }
        }
#pragma unroll
        for (int i = 0; i < 4; ++i) { const int t = w * 16 + fq * 4 + i; const float bias = bias4[i];
            bf16_t* op = WSP(bf16_t, WS_MIX) + (size_t)(b * SEQ + n * 128 + t) * DM + 512 + g * 64 + fr;
#pragma unroll
            for (int ct = 0; ct < 4; ++ct) op[ct * 16] = (bf16_t)f2bf(bf2f(uu[i][ct]) * (acc[ct][i] + bias)); }
    }
}

__device__ __forceinline__ void attn_sample_item(const Ctx& C, int l, int b) {
    const int hq = C.wave, lane = C.lane, kvh = hq >> 2;
    LAS float* qs = (LAS float*)C.lds + hq * 128; LAS float* ks = qs + 64;
    const bf16_t* rp = WSP(bf16_t, WS_PROJ) + (size_t)(MP + b) * DIN;
    const float* rr = WSP(float, WS_ROPE) + (size_t)8192 * 16;
    float qd = bf2f(rp[hq * 64 + lane]), kd = bf2f(rp[512 + kvh * 64 + lane]); const float vd = bf2f(rp[640 + kvh * 64 + lane]);
    {
        const float qo = __shfl_xor(qd, 8), ko = __shfl_xor(kd, 8);
        if (lane < 16) { const float cs = rr[lane & 7], sn = rr[8 + (lane & 7)];
            qd = (lane < 8) ? (qd * cs - qo * sn) : (qd * cs + qo * sn); kd = (lane < 8) ? (kd * cs - ko * sn) : (kd * cs + ko * sn); }
    }
    __syncthreads();
    qs[lane] = qd; ks[lane] = kd;
    if ((hq & 3) == 0) { C.out[O_KNEW + (size_t)((l * 128 + b) * 2 + kvh) * 64 + lane] = kd; C.out[O_VNEW + (size_t)((l * 128 + b) * 2 + kvh) * 64 + lane] = vd; }
    __syncthreads();
    const float* ck = IN(2) + ((size_t)(l * 128 + b) * 128 * 2 + kvh) * 64; const float* cv = IN(3) + ((size_t)(l * 128 + b) * 128 * 2 + kvh) * 64;
    float s0 = 0.f, s1 = 0.f;
    {
        const float* k0 = ck + (size_t)(lane + 1) * 128; const float* k1 = (lane < 63) ? ck + (size_t)(lane + 65) * 128 : k0;
        {
            f32x4 ka[16];
#pragma unroll
            for (int d = 0; d < 16; ++d) ka[d] = *(const f32x4*)(k0 + 4 * d);
#pragma unroll
            for (int d = 0; d < 16; ++d) { const f32x4 qv = *(const LAS f32x4*)(qs + 4 * d); s0 += ka[d].x * qv.x + ka[d].y * qv.y + ka[d].z * qv.z + ka[d].w * qv.w; }
        }
        asm volatile("" ::: "memory");
        {
            f32x4 kb[16];
#pragma unroll
            for (int d = 0; d < 16; ++d) kb[d] = *(const f32x4*)(k1 + 4 * d);
#pragma unroll
            for (int d = 0; d < 16; ++d) { const f32x4 qv = *(const LAS f32x4*)(qs + 4 * d); s1 += kb[d].x * qv.x + kb[d].y * qv.y + kb[d].z * qv.z + kb[d].w * qv.w; }
        }
        const float snew = wave_sum(qd * kd);
        if (lane == 63) s1 = snew;
    }
    s0 *= 0.125f; s1 *= 0.125f;
    const float sink = IN(9)[l * 8 + hq];
    const float mx = fmaxf(wave_max(fmaxf(s0, s1)), sink);
    const float p0 = __expf(s0 - mx), p1 = __expf(s1 - mx);
    const float sum = wave_sum(p0 + p1) + __expf(sink - mx);
    asm volatile("" ::: "memory");
    const int g4 = lane >> 4, d4 = (lane & 15) * 4;
    f32x4 o4 = (f32x4){0.f, 0.f, 0.f, 0.f};
#pragma unroll 1
    for (int i0 = 0; i0 < 32; i0 += 8) {
        f32x4 vv[8];
#pragma unroll
        for (int j = 0; j < 8; ++j) { const int x = 4 * (i0 + j) + g4; vv[j] = (f32x4){0.f, 0.f, 0.f, 0.f}; if (x < 127) vv[j] = *(const f32x4*)(cv + (size_t)(x + 1) * 128 + d4); }
#pragma unroll
        for (int j = 0; j < 8; ++j) { const int x = 4 * (i0 + j) + g4; const float p = __shfl(i0 < 16 ? p0 : p1, x & 63); o4 += vv[j] * p; }
    }
    { const float pn = __shfl(p1, 63); const float vn0 = __shfl(vd, d4), vn1 = __shfl(vd, d4 + 1), vn2 = __shfl(vd, d4 + 2), vn3 = __shfl(vd, d4 + 3);
      if (g4 == 0) o4 += (f32x4){vn0, vn1, vn2, vn3} * pn; }
#pragma unroll
    for (int e = 0; e < 4; ++e) { o4[e] += __shfl_xor(o4[e], 16); o4[e] += __shfl_xor(o4[e], 32); }
    if (lane < 16) { const float rs = 1.0f / sum; u32x2 wv; wv.x = pk2(o4.x * rs, o4.y * rs); wv.y = pk2(o4.z * rs, o4.w * rs);
        *(u32x2*)(WSP(bf16_t, WS_MIX) + (size_t)(MP + b) * DM + hq * 64 + d4) = wv; }
}
__device__ __forceinline__ void hgrn_sample_wave(const Ctx& C, int l, int wi) {
    const int b = wi >> 2, h = wi & 3, lane = C.lane;
    const bf16_t* rp = WSP(bf16_t, WS_PROJ) + (size_t)(MP + b) * DIN;
    const float lbv = hgrn_lb(C, l, h * 64 + lane);
    const float f = lbv + (1.0f - lbv) * sigmoid_f(bf2f(rp[1536 + h * 64 + lane])), kk = 1.0f - f;
    const float q = bf2f(rp[1280 + h * 64 + lane]), iv = bf2f(rp[1792 + h * 64 + lane]), cg = bf2f(rp[2048 + h * 64 + lane]);
    const float* S0 = IN(4) + (size_t)((l * 128 + b) * 4 + h) * 4096; float* So = C.out + O_HSS + (size_t)((l * 128 + b) * 4 + h) * 4096;
    float o = 0.f;
#pragma unroll 16
    for (int k = 0; k < 64; ++k) { const float fk = __shfl(f, k), kkk = __shfl(kk, k), qk = __shfl(q, k);
        const float S = fk * S0[k * 64 + lane] + kkk * iv; So[k * 64 + lane] = S; o += qk * S; }
    const float ms = wave_sum(o * o) * (1.0f / 64.0f);
    const float y = o * (1.0f / sqrtf(ms + 1e-6f)) * IN(15)[l * 64 + lane] * silu2(cg);
    WSP(bf16_t, WS_MIX)[(size_t)(MP + b) * DM + 768 + h * 64 + lane] = (bf16_t)f2bf(y);
}
__device__ __forceinline__ void gmlp_sample_wave(const Ctx& C, int l, int b) {
    const int lane = C.lane, c = 4 * lane, g = c >> 6;
    const bf16_t* rp = WSP(bf16_t, WS_PROJ) + (size_t)(MP + b) * DIN;
    const u32x2 gw = *(const u32x2*)(rp + 1024 + c), uw = *(const u32x2*)(rp + 768 + c);
    float x[4] = {bf2f(gw.x & 0xffffu), bf2f(gw.x >> 16), bf2f(gw.y & 0xffffu), bf2f(gw.y >> 16)};
    const float u[4] = {bf2f(uw.x & 0xffffu), bf2f(uw.x >> 16), bf2f(uw.y & 0xffffu), bf2f(uw.y >> 16)};
    const float mean = wave_sum(x[0] + x[1] + x[2] + x[3]) * (1.0f / 256.0f);
    float sq = 0.f;
#pragma unroll
    for (int i = 0; i < 4; ++i) { x[i] -= mean; sq += x[i] * x[i]; }
    const float rstd = 1.0f / sqrtf(wave_sum(sq) * (1.0f / 256.0f) + 1e-5f);
    const float w00 = IN(12)[(size_t)(l * 4 + g) * 128 * 128], b0 = IN(13)[(l * 4 + g) * 128];
    float vn[4], y[4];
#pragma unroll
    for (int i = 0; i < 4; ++i) { vn[i] = x[i] * rstd * IN(10)[l * 256 + c + i] + IN(11)[l * 256 + c + i]; y[i] = u[i] * (w00 * vn[i] + b0); }
    *(f32x4*)(C.out + O_GV + (size_t)(l * 128 + b) * 256 + c) = (f32x4){vn[0], vn[1], vn[2], vn[3]};
    u32x2 wv; wv.x = pk2(y[0], y[1]); wv.y = pk2(y[2], y[3]);
    *(u32x2*)(WSP(bf16_t, WS_MIX) + (size_t)(MP + b) * DM + 512 + c) = wv;
}

__device__ __forceinline__ void sample_gemm(const Ctx& C, const bf16_t* A, int K, const bf16_t* Bt) {
    int lane = C.lane; asm volatile("" : "+v"(lane));
    const int fr = lane & 15, fq = lane >> 4, kl = K >> 2;
    for (int it = C.bid; it < 256; it += C.G) {
        const int cgp = it & 63, ks = it >> 6;
        const bf16_t* ap = A + (size_t)(C.wave * 16 + fr) * K + ks * kl + fq * 8; const bf16_t* bp = Bt + (size_t)(cgp * 16 + fr) * K + ks * kl + fq * 8;
        f32x4 acc = (f32x4){0.f, 0.f, 0.f, 0.f};
        if (kl == 704) {
#pragma unroll 1
            for (int s0 = 0; s0 < 704; s0 += 352) { bf16x8 av[11], bv[11];
#pragma unroll
                for (int j = 0; j < 11; ++j) { av[j] = *(const bf16x8*)(ap + s0 + 32 * j); bv[j] = *(const bf16x8*)(bp + s0 + 32 * j); }
#pragma unroll
                for (int j = 0; j < 11; ++j) acc = __builtin_amdgcn_mfma_f32_16x16x32_bf16(av[j], bv[j], acc, 0, 0, 0); }
        } else {
#pragma unroll 8
            for (int s = 0; s < kl; s += 32) acc = __builtin_amdgcn_mfma_f32_16x16x32_bf16(*(const bf16x8*)(ap + s), *(const bf16x8*)(bp + s), acc, 0, 0, 0);
        }
        float* yo = WSP(float, WS_YS) + ((size_t)ks * 128 + C.wave * 16 + fq * 4) * DM + cgp * 16 + fr;
#pragma unroll
        for (int i = 0; i < 4; ++i) yo[(size_t)i * DM] = acc[i];
    }
}

#define FRESH_CTX(C2, C) Ctx C2 = (C); { int z2_; asm volatile("s_mov_b32 %0, 0" : "=s"(z2_)); C2.ws = (C).ws + z2_; C2.out = (C).out + z2_; C2.in = (C).in + z2_; }
#ifndef XMODE
#define XMODE 0
#endif
__device__ __forceinline__ void phase_mix1(const Ctx& C, int l, int rep = 0) {
    if (!rep) for (int it = C.bid; it < 256; it += C.G) { FRESH_CTX(C2, C); attn_prompt_item(C2, l, it); }
    for (int it = C.bid; it < 256; it += C.G) { FRESH_CTX(C2, C); hgrn_local_item(C2, l, it, rep ? XMODE : 0); }
}
__device__ __forceinline__ void phase_mix2(const Ctx& C, int l, int rep = 0) {
    if (rep == 0) hgrn_scan(C, l);
#ifndef T_AS
#define T_AS 1
#define T_GP 1
#define T_HS 1
#define T_GS 1
#endif
    if (T_AS) for (int it = C.bid; it < 128; it += C.G) attn_sample_item(C, l, it);
    if (T_GP) for (int it = C.bid; it < 512; it += C.G) { FRESH_CTX(C2, C); gmlp_prompt_item(C2, l, it); }
    if (T_HS) for (int it = (C.bid + 128) % C.G; it < 64; it += C.G) hgrn_sample_wave(C, l, it * 8 + C.wave);
    if (T_GS) for (int it = (C.bid + 64) % C.G; it < 16; it += C.G) gmlp_sample_wave(C, l, it * 8 + C.wave);
}
__device__ __forceinline__ void phase_mix3(const Ctx& C, int l) {
    for (int it = C.bid; it < 256; it += C.G) { FRESH_CTX(C2, C); hgrn_corr_item(C2, l, it); }
}

#define XB_TMO      128
#define XB_XCNT(j)  (256  + 64 * (j))
#define XB_XSUB(j)  (1280 + 64 * (j))
#define XB_XGEN(j)  (2304 + 64 * (j))
#define XB_TOP      3328
#define XB_TOPGEN   3392
#define XCD_BAR_WORDS 3456
#define XB_SPIN_CAP (1u << 18)

__device__ __forceinline__ unsigned xb_ld(unsigned* p)              { return __hip_atomic_load(p, __ATOMIC_RELAXED, __HIP_MEMORY_SCOPE_AGENT); }
__device__ __forceinline__ unsigned xb_add(unsigned* p, unsigned v) { return __hip_atomic_fetch_add(p, v, __ATOMIC_RELAXED, __HIP_MEMORY_SCOPE_AGENT); }
__device__ __forceinline__ unsigned xb_xcc_id() { return (unsigned)__builtin_amdgcn_s_getreg((3 << 11) | 20) & 0xFu; }
#define XB_SPIN(cond, bar) do { unsigned _sp = 0; while (cond) { __builtin_amdgcn_s_sleep(1); \
    if ((++_sp & 255u) == 0u) { if (xb_ld(&(bar)[XB_TMO])) break; if (_sp > XB_SPIN_CAP) { atomicAdd(&(bar)[XB_TMO], 1u); break; } } } } while (0)

struct XcdBarrier {
    unsigned* bar; unsigned x;
    volatile LAS unsigned* st;
};

__device__ __forceinline__ XcdBarrier xcd_barrier_post(unsigned* bar, volatile LAS unsigned* st) {
    XcdBarrier b; b.bar = bar; b.x = xb_xcc_id(); b.st = st;
    if (threadIdx.x == 0) (void)xb_add(&bar[XB_XCNT(b.x)], 1u);
    return b;
}
__device__ __forceinline__ void xcd_barrier_complete(unsigned* bar, unsigned x, unsigned& nloc, unsigned& nx) {
    const unsigned G = gridDim.x * gridDim.y * gridDim.z;
    unsigned sum, cnt, mine, sp = 0u;
    for (;;) {
        sum = 0u; cnt = 0u; mine = 0u;
#pragma unroll
        for (unsigned j = 0; j < 16; ++j) { const unsigned c = xb_ld(&bar[XB_XCNT(j)]); sum += c; cnt += (c > 0u) ? 1u : 0u; mine = (j == x) ? c : mine; }
        if (sum == G) break;
        __builtin_amdgcn_s_sleep(1);
        if ((++sp & 255u) == 0u) { if (xb_ld(&bar[XB_TMO])) break; if (sp > XB_SPIN_CAP) { atomicAdd(&bar[XB_TMO], 1u); break; } }
    }
    nloc = mine > 0u ? mine : 1u; nx = cnt > 0u ? cnt : 1u;
}

__device__ __forceinline__ void xcd_barrier(const XcdBarrier& b) {
    asm volatile("s_waitcnt vmcnt(0)" ::: "memory");
    __syncthreads();
    if (threadIdx.x == 0) {
        unsigned* bar = b.bar;
        __builtin_amdgcn_s_waitcnt(0);
        unsigned nloc = b.st[0], nx = b.st[1];
        if (nloc == 0u) { xcd_barrier_complete(bar, b.x, nloc, nx); b.st[0] = nloc; b.st[1] = nx; }
        const unsigned old = xb_add(&bar[XB_XSUB(b.x)], 1u);
        const unsigned gen = old / nloc;
        if (old + 1u == (gen + 1u) * nloc) {
            __builtin_amdgcn_fence(__ATOMIC_RELEASE, "agent");
            asm volatile("s_waitcnt vmcnt(0)" ::: "memory");
            const unsigned og = xb_add(&bar[XB_TOP], 1u);
            const unsigned tg = og / nx;
            if (og + 1u == (tg + 1u) * nx) xb_add(&bar[XB_TOPGEN], 1u);
            else XB_SPIN(xb_ld(&bar[XB_TOPGEN]) == tg, bar);
            __builtin_amdgcn_fence(__ATOMIC_ACQUIRE, "agent");
            asm volatile("s_waitcnt vmcnt(0)" ::: "memory");
        } else {
            XB_SPIN(xb_ld(&bar[XB_TOPGEN]) == gen, bar);
            __builtin_amdgcn_fence(__ATOMIC_ACQUIRE, "agent");
            asm volatile("s_waitcnt vmcnt(0)" ::: "memory");
        }
    }
    __syncthreads();
}

#ifndef T_PRO
#define T_PRO 1
#endif
#ifndef T_G1
#define T_G1 1
#endif
#ifndef T_G2
#define T_G2 1
#endif
#ifndef T_G3
#define T_G3 1
#endif
#ifndef T_M1
#define T_M1 1
#endif
#ifndef T_M2
#define T_M2 1
#endif
#ifndef T_M3
#define T_M3 1
#endif
__global__ void __launch_bounds__(512, 2) mega_fwd(Args args) {
    extern __shared__ __attribute__((aligned(16))) unsigned char lds[];
    Ctx C;
    C.lds = (LAS unsigned char*)lds; C.tid = threadIdx.x; C.lane = C.tid & 63; C.wave = __builtin_amdgcn_readfirstlane(C.tid >> 6);
    C.G = gridDim.x; C.bid = blockIdx.x; C.in = args.in; C.out = args.out; C.ws = args.ws;
    cg::grid_group grid = cg::this_grid();
    volatile LAS unsigned* bst = (volatile LAS unsigned*)(C.lds + LDS_BYTES - 64);
    if (C.tid < 2) bst[C.tid] = 0u;
    __syncthreads();
    const XcdBarrier xbar = xcd_barrier_post((unsigned*)(args.ws + 16384), bst);
    const Ctx C0 = C;
#ifndef XDUP
#define XDUP (-1)
#endif
#ifndef XDUPN
#define XDUPN 1
#endif
    for (int pi_ = args.ph_lo; pi_ < args.ph_hi + (XDUP >= 0 ? XDUPN : 0); ++pi_) {
        int ph = pi_, XR_ = 0;
        if (XDUP >= 0 && pi_ >= XDUP) { const int o_ = pi_ - XDUP; if (o_ < 2 * XDUPN) { ph = XDUP + (o_ >> 1); XR_ = o_ & 1; } else ph = pi_ - XDUPN; }
        {
            int z_; int t_ = C0.tid;
            asm volatile("s_mov_b32 %0, 0" : "=s"(z_)); asm volatile("" : "+v"(t_));
            C.ws = C0.ws + z_; C.out = C0.out + z_; C.in = C0.in + z_; C.tid = t_; C.lane = t_ & 63;
        }
        if (ph == 0) { if (T_PRO) phase_prologue(C, XR_); }
        else if (ph == 1) phase_mod0(C);
        else {
            const int l = (ph - 2) / 12, s = (ph - 2) % 12;
            if (T_G1 && (s == 0 || s == 9 || s == 1 || s == 10 || s == 7 || s == 3)) {
                const int f2 = (s >= 9) ? 1 : 0, mi = l * 2 + f2;
                pg8::Gemm g; pg8::EpiMulti E; E.O = nullptr; E.ldc = 0; E.X = nullptr; E.Xw = nullptr; E.gate = nullptr; E.scale = 0.f; E.Xf = nullptr; E.ST = nullptr; E.pg = nullptr; E.pb = nullptr;
                { const int li = l * 3 + (s == 1 ? 0 : s == 7 ? 1 : 2);
                  if (s == 1 || s == 7 || s == 10) { if (li == 0) E.Xf = IN(0); else { E.ST = WSP(float, WS_ST); E.pg = IN(22) + (size_t)(li - 1) * DM; E.pb = IN(23) + (size_t)(li - 1) * DM; } } }
                if (s == 0 || s == 9) {
                    g = pg8::Gemm{WSP(pg8::bf16_t, WS_H), WSP(pg8::bf16_t, WS_FFIN) + (size_t)mi * 2 * DFF * DM, MPAD, 2 * DFF, DM};
                    E.mode = 0; E.O = WSP(pg8::bf16_t, WS_ACT); E.ldc = DFF;
                } else if (s == 1 || s == 10) {
                    g = pg8::Gemm{WSP(pg8::bf16_t, WS_ACT), WSP(pg8::bf16_t, WS_FFOUT) + (size_t)mi * DM * DFF, MP, DM, DFF};
                    E.mode = 2; E.X = WSP(pg8::bf16_t, WS_XB); E.gate = WSP(float, WS_MOD) + (size_t)l * NCROW * MODW + (size_t)(s == 1 ? 2 : 8) * DM; E.scale = 0.5f;
                } else if (s == 7) {
                    g = pg8::Gemm{WSP(pg8::bf16_t, WS_MIX), WSP(pg8::bf16_t, WS_WOUT) + (size_t)l * DM * DM, MP, DM, DM};
                    E.mode = 2; E.X = WSP(pg8::bf16_t, WS_XB); E.gate = WSP(float, WS_MOD) + (size_t)l * NCROW * MODW + (size_t)5 * DM; E.scale = 1.0f;
                } else {
                    g = pg8::Gemm{WSP(pg8::bf16_t, WS_H), WSP(pg8::bf16_t, WS_WIN) + (size_t)l * DIN * DM, MPAD, DIN, DM};
                    E.mode = 1; E.O = WSP(pg8::bf16_t, WS_PROJ); E.ldc = DIN;
                }
                E.Xw = XR_ ? (pg8::bf16_t*)(C.ws + 273 * MiB) : E.X;
                pg8::StaticOrder S; S.init(g.M, g.N, C.G, C.bid);
                pg8::gemm_phase<pg8::EpiMulti, pg8::StaticOrder, true, true>(C.lds, g, S, E);
                if (E.mode == 2) sample_gemm(C, g.A + (size_t)MP * g.K, g.K, g.Bt);
            } else if (s == 2) phase_ln(C, l, 0, XR_);
            else if (s == 8) phase_ln(C, l, 1, XR_);
            else if (s == 11) phase_ln(C, l, 2, (l == 1) ? 0 : XR_);
            else if (s == 4) { if (T_M1) phase_mix1(C, l, XR_); }
            else if (s == 5) { if (T_M2) phase_mix2(C, l, XR_); }
            else { if (T_M3) phase_mix3(C, l); }
        }
        if (pi_ + 1 < args.ph_hi + (XDUP >= 0 ? XDUPN : 0)) { if (args.ph_lo < 0) grid.sync(); else xcd_barrier(xbar); }
    }
}

#ifndef MK_ONE_LAUNCH
#define MK_ONE_LAUNCH 1
#endif
extern "C" void kernel_launch(void* const* d_in, const int* in_sizes, int n_in, void* d_out, int out_size, void* d_ws, size_t ws_size, hipStream_t stream) {
    static int grid = 0;
    if (grid == 0) {
        if (n_in != 24 || ws_size < WS_END) { fprintf(stderr, "kernel_launch: unexpected n_in %d / ws %zu\n", n_in, ws_size); grid = -1; return; }
        int dev = 0, cus = 0, per_cu = 0;
        (void)hipGetDevice(&dev); (void)hipDeviceGetAttribute(&cus, hipDeviceAttributeMultiprocessorCount, dev);
        if (hipFuncSetAttribute((const void*)mega_fwd, hipFuncAttributeMaxDynamicSharedMemorySize, LDS_BYTES) != hipSuccess) { fprintf(stderr, "kernel_launch: hipFuncSetAttribute failed\n"); grid = -1; return; }
        if (hipOccupancyMaxActiveBlocksPerMultiprocessor(&per_cu, (const void*)mega_fwd, 512, LDS_BYTES) != hipSuccess || per_cu < 1) { fprintf(stderr, "kernel_launch: occupancy query gave %d\n", per_cu); per_cu = 1; }
        (void)hipGetLastError();
        grid = cus > 0 ? cus : 256;
    }
    if (grid < 0) return;
    (void)hipMemsetAsync(d_ws, 0, 65536, stream);
    Args a{};
    for (int i = 0; i < 24; ++i) a.in[i] = (const float*)d_in[i];
    a.out = (float*)d_out; a.ws = (unsigned char*)d_ws;
#if MK_ONE_LAUNCH
    a.ph_lo = 0; a.ph_hi = NPH;
    void* kargs[] = {&a};
    hipError_t e = hipLaunchCooperativeKernel((const void*)mega_fwd, dim3(grid), dim3(512), kargs, LDS_BYTES, stream);
    if (e != hipSuccess) fprintf(stderr, "kernel_launch: cooperative launch failed: %s (grid %d)\n", hipGetErrorString(e), grid);
#else
    for (int ph = 0; ph < NPH; ++ph) { a.ph_lo = ph; a.ph_hi = ph + 1; hipLaunchKernelGGL(mega_fwd, dim3(grid), dim3(512), LDS_BYTES, stream, a); }
#endif
}
```

```cpp
#include <hip/hip_runtime.h>
#include <hip/hip_cooperative_groups.h>
#include <cstdio>
#include <cstdint>
namespace cg = cooperative_groups;

constexpr int DM = 1024, SEQ = 8192, MP = 16384, DECB = 128, MR = MP + DECB, MPAD = 16640;
constexpr int DIN = 2304, DFF = 2816, MODW = 9216, NCROW = 130, DEPTH = 2;
constexpr float ALPHA_F = 1.41421356237f;
__device__ __forceinline__ int crow_of(int r) { return r < MP ? (r >> 13) : (r < MR ? 2 + (r - MP) : 129); }

namespace pg8 {
#define PG8_LAS __attribute__((address_space(3)))
typedef unsigned short bf16_t;
typedef short bf16x8 __attribute__((ext_vector_type(8)));
typedef float f32x4 __attribute__((ext_vector_type(4)));
typedef unsigned u32x4 __attribute__((ext_vector_type(4)));
constexpr int BM = 256, BK = 64, HALF = 128, HTB = HALF * BK * 2  , STAGE_BYTES = 8 * HTB, NXCD = 8, WGM = 8;

__host__ __device__ __forceinline__ int lds_byte(int r, int c) { const int st = (r >> 4) * 2 + (c >> 5), rr = r & 15, cc = c & 31, ob = rr * 64 + cc * 2; return st * 1024 + (ob ^ (((ob >> 9) & 1) << 5)); }
__host__ __device__ __forceinline__ void stage_rc(int b, int& R, int& C) { const int st = b / 1024, sb = b % 1024, swz = sb ^ (((sb >> 9) & 1) << 5); R = (st >> 1) * 16 + swz / 64; C = (st & 1) * 32 + (swz % 64) / 2; }
__host__ __device__ __forceinline__ int perm32(int rho) { const int n = rho >> 4, i = rho & 15; return 8 * (i >> 2) + 4 * n + (i & 3); }

struct Unit { int pm, pn; };
struct Gemm { const bf16_t* A; const bf16_t* Bt; int M, N, K; };

struct StaticOrder {
    int nM, nN, nwg, G, c;
    __host__ __device__ void init(int M, int N, int G_, int c_) { nM = M / BM; nN = N / BM; nwg = nM * nN; G = G_; c = c_; }
    __host__ __device__ bool next(int i, Unit& u) const {
        const long L = (long)i * G + c; if (L >= nwg) return false;
        int wgid = (int)L; { const int q = nwg / NXCD, r = nwg % NXCD, xcd = wgid % NXCD, off = wgid / NXCD; wgid = (xcd < r ? xcd * (q + 1) : r * (q + 1) + (xcd - r) * q) + off; }
        const int nig = WGM * nN, gid = wgid / nig, fm = gid * WGM, gsz = (nM - fm) < WGM ? (nM - fm) : WGM;
        u.pm = fm + ((wgid % nig) % gsz); u.pn = (wgid % nig) / gsz; return true;
    }
    __device__ __forceinline__ void a_ready(const Unit&) const {}
    __device__ __forceinline__ void done(const Unit&) const {}
};

__device__ __forceinline__ unsigned cvt_pk_bf16(float lo, float hi) { unsigned r; asm volatile("v_cvt_pk_bf16_f32 %0, %1, %2" : "=v"(r) : "v"(lo), "v"(hi)); return r; }
typedef float f32x2 __attribute__((ext_vector_type(2)));

__device__ __forceinline__ float silu_f(float g) { return g * __builtin_amdgcn_rcpf(1.0f + __expf(-g)); }
struct EpiSwiglu {
    static constexpr bool PERM = true, AFTER_DRAIN = false;
    bf16_t* O;
    __device__ __forceinline__ void operator()(const f32x4 (&acc)[2][2][4][2], const Unit& u, int wr, int wc, int fr, int fq) const {
        const int row0 = u.pm * BM + wr * 64 + fr, col0 = u.pn * HALF + wc * 32 + 8 * fq;
#pragma unroll
        for (int ai = 0; ai < 2; ++ai)
#pragma unroll
            for (int m = 0; m < 4; ++m) {
                bf16_t* rowp = O + (size_t)(row0 + ai * HALF + m * 16) * DFF + col0;
                const f32x4 a0 = acc[ai][0][m][0], a1 = acc[ai][0][m][1], g0 = acc[ai][1][m][0], g1 = acc[ai][1][m][1];
                u32x4 w;
                w.x = cvt_pk_bf16(silu_f(g0[0]) * a0[0], silu_f(g0[1]) * a0[1]); w.y = cvt_pk_bf16(silu_f(g0[2]) * a0[2], silu_f(g0[3]) * a0[3]);
                w.z = cvt_pk_bf16(silu_f(g1[0]) * a1[0], silu_f(g1[1]) * a1[1]); w.w = cvt_pk_bf16(silu_f(g1[2]) * a1[2], silu_f(g1[3]) * a1[3]);
                *(u32x4*)rowp = w;
            }
    }
};
struct EpiStore {
    static constexpr bool PERM = true, AFTER_DRAIN = false;
    bf16_t* O; int ldc;
    __device__ __forceinline__ void operator()(const f32x4 (&acc)[2][2][4][2], const Unit& u, int wr, int wc, int fr, int fq) const {
        const int row0 = u.pm * BM + wr * 64 + fr, col0 = u.pn * BM + wc * 32 + 8 * fq;
#pragma unroll
        for (int ai = 0; ai < 2; ++ai)
#pragma unroll
            for (int m = 0; m < 4; ++m) {
                bf16_t* rowp = O + (size_t)(row0 + ai * HALF + m * 16) * ldc + col0;
#pragma unroll
                for (int bj = 0; bj < 2; ++bj) {
                    const f32x4 v0 = acc[ai][bj][m][0], v1 = acc[ai][bj][m][1];
                    u32x4 w; w.x = cvt_pk_bf16(v0[0], v0[1]); w.y = cvt_pk_bf16(v0[2], v0[3]); w.z = cvt_pk_bf16(v1[0], v1[1]); w.w = cvt_pk_bf16(v1[2], v1[3]);
                    *(u32x4*)(rowp + bj * HALF) = w;
                }
            }
    }
};
struct EpiResid {
    static constexpr bool PERM = false, AFTER_DRAIN = false;
    float* X; const float* gate; float scale;
    __device__ __forceinline__ void operator()(const f32x4 (&acc)[2][2][4][2], const Unit& u, int wr, int wc, int fr, int fq) const {
#pragma unroll
        for (int ai = 0; ai < 2; ++ai)
#pragma unroll
            for (int m = 0; m < 4; ++m) {
                const int r = u.pm * BM + ai * HALF + wr * 64 + m * 16 + fr;
                if (r < MR) {
                    const float* gp = gate + (size_t)crow_of(r) * MODW; float* xp = X + (size_t)r * DM;
#pragma unroll
                    for (int bj = 0; bj < 2; ++bj)
#pragma unroll
                        for (int n = 0; n < 2; ++n) {
                            const int c = u.pn * BM + bj * HALF + wc * 32 + n * 16 + 4 * fq;
                            const f32x4 gv = *(const f32x4*)(gp + c); const f32x4 xv = *(const f32x4*)(xp + c);
                            *(f32x4*)(xp + c) = xv * ALPHA_F + (gv + 1.0f) * (acc[ai][bj][m][n] * scale);
                        }
                }
            }
    }
};

struct EpiMulti {
    static constexpr bool PERM = true, AFTER_DRAIN = false;
    int mode; bf16_t* O; int ldc; bf16_t* X; bf16_t* Xw; const float* gate; float scale;
    const float* Xf; const float* ST; const float* pg; const float* pb;
    __device__ __forceinline__ void operator()(const f32x4 (&acc)[2][2][4][2], const Unit& u, int wr, int wc, int fr, int fq) const {
        if (mode == 0) { EpiSwiglu e{O}; e(acc, u, wr, wc, fr, fq); }
        else { EpiStore e{O, ldc}; e(acc, u, wr, wc, fr, fq); }
    }
    __device__ __forceinline__ bool after_drain() const { return mode == 2; }
    __device__ __forceinline__ void fused(const f32x4 (&acc)[2][2][4][2], const Unit& u, int wr, int wc, int fr, int fq, PG8_LAS unsigned char*, int, int) const {
        {
            const int r0 = u.pm * BM + wr * 64 + fr, cb = u.pn * BM + wc * 32 + 8 * fq;
            const float* gp = gate + (size_t)crow_of(u.pm * BM) * MODW + cb;
            f32x4 G[2][2];
#pragma unroll
            for (int bj = 0; bj < 2; ++bj) { G[bj][0] = *(const f32x4*)(gp + bj * HALF) + 1.0f; G[bj][1] = *(const f32x4*)(gp + bj * HALF + 4) + 1.0f; }
            if (Xf != nullptr) {
#pragma unroll
                for (int ai = 0; ai < 2; ++ai)
#pragma unroll
                    for (int m = 0; m < 4; ++m) { const int r = r0 + ai * HALF + m * 16;
#pragma unroll
                        for (int bj = 0; bj < 2; ++bj) { const float* sp = Xf + (size_t)r * DM + cb + bj * HALF;
                            const f32x4 z0 = *(const f32x4*)sp * ALPHA_F + G[bj][0] * (acc[ai][bj][m][0] * scale), z1 = *(const f32x4*)(sp + 4) * ALPHA_F + G[bj][1] * (acc[ai][bj][m][1] * scale);
                            u32x4 o; o.x = cvt_pk_bf16(z0[0], z0[1]); o.y = cvt_pk_bf16(z0[2], z0[3]); o.z = cvt_pk_bf16(z1[0], z1[1]); o.w = cvt_pk_bf16(z1[2], z1[3]);
                            *(u32x4*)(Xw + (size_t)r * DM + cb + bj * HALF) = o; } }
            } else {
#pragma unroll
                for (int bj = 0; bj < 2; ++bj) {
                    const int cc = cb + bj * HALF;
                    const f32x4 PG0 = *(const f32x4*)(pg + cc), PG1 = *(const f32x4*)(pg + cc + 4), PB0 = *(const f32x4*)(pb + cc), PB1 = *(const f32x4*)(pb + cc + 4);
                    u32x4 nx = *(const u32x4*)(X + (size_t)r0 * DM + cc); float nmean = ST[2 * r0], nrstd = ST[2 * r0 + 1];
#pragma unroll
                    for (int idx = 0; idx < 8; ++idx) {
                        const int ai = idx >> 2, m = idx & 3, r = r0 + ai * HALF + m * 16;
                        const u32x4 w = nx; const float mean = nmean, rstd = nrstd;
                        if (idx < 7) { const int rn = r0 + ((idx + 1) >> 2) * HALF + ((idx + 1) & 3) * 16; nx = *(const u32x4*)(X + (size_t)rn * DM + cc); nmean = ST[2 * rn]; nrstd = ST[2 * rn + 1]; }
                        f32x4 x0 = (f32x4){__uint_as_float(w.x << 16), __uint_as_float(w.x & 0xffff0000u), __uint_as_float(w.y << 16), __uint_as_float(w.y & 0xffff0000u)};
                        f32x4 x1 = (f32x4){__uint_as_float(w.z << 16), __uint_as_float(w.z & 0xffff0000u), __uint_as_float(w.w << 16), __uint_as_float(w.w & 0xffff0000u)};
                        x0 = (x0 - mean) * rstd * PG0 + PB0; x1 = (x1 - mean) * rstd * PG1 + PB1;
                        const f32x4 z0 = x0 * ALPHA_F + G[bj][0] * (acc[ai][bj][m][0] * scale), z1 = x1 * ALPHA_F + G[bj][1] * (acc[ai][bj][m][1] * scale);
                        u32x4 o; o.x = cvt_pk_bf16(z0[0], z0[1]); o.y = cvt_pk_bf16(z0[2], z0[3]); o.z = cvt_pk_bf16(z1[0], z1[1]); o.w = cvt_pk_bf16(z1[2], z1[3]);
                        *(u32x4*)(Xw + (size_t)r * DM + cc) = o;
                        asm volatile("" ::: "memory");
                    }
                }
            }
        }
    }
};
template <class Epi, class Sched, bool ALIGN_EPI = false, bool SP2 = false>
__device__ __forceinline__ void gemm_phase(PG8_LAS unsigned char* lds, const Gemm g, const Sched& S, const Epi& E) {
    const int tid = threadIdx.x, wid = __builtin_amdgcn_readfirstlane(tid >> 6), lane = tid & 63, wr = wid >> 2, wc = wid & 3, fr = lane & 15, fq = lane >> 4;
    const int K = g.K, nt = K / BK;
    unsigned voffA[2], voffB[2];
#pragma unroll
    for (int i = 0; i < 2; ++i) { int R, C; stage_rc(tid * 16 + i * 8192, R, C); const int Rb = Epi::PERM ? ((R & ~31) + perm32(R & 31)) : R;
        voffA[i] = (unsigned)(R * K + C) * 2u; voffB[i] = (unsigned)(Rb * K + C) * 2u; }
    const size_t kstep = (size_t)(BK * 2);
    const size_t hstep = (size_t)HALF * K * 2;
    const size_t tstep = 2 * hstep;
    const unsigned ldsw = (unsigned)wid * 1024u;
    const int aoff = lds_byte(wr * 64 + fr, fq * 8), boff = lds_byte(wc * 32 + fr, fq * 8);
#define PG8_SA(b, h) (((b) * 2 + (h)) * HTB)
#define PG8_SB(b, h) ((4 + (b) * 2 + (h)) * HTB)
#define PG8_STAGE(bufoff, gbase, voff) do { _Pragma("unroll") for (int _i = 0; _i < 2; ++_i) \
        __builtin_amdgcn_global_load_lds((const unsigned*)((const char*)(gbase) + (voff)[_i]), (PG8_LAS unsigned*)(lds + (bufoff) + ldsw + _i * 8192), 16, 0, 0); } while (0)
#define PG8_LDA(dst, b, h) do { _Pragma("unroll") for (int m = 0; m < 4; ++m) _Pragma("unroll") for (int k = 0; k < 2; ++k) dst[m][k] = *(const PG8_LAS bf16x8*)(lds + PG8_SA(b, h) + aoff + m * 2048 + k * 1024); } while (0)
#define PG8_LDB(dst, b, h) do { _Pragma("unroll") for (int n = 0; n < 2; ++n) _Pragma("unroll") for (int k = 0; k < 2; ++k) dst[n][k] = *(const PG8_LAS bf16x8*)(lds + PG8_SB(b, h) + boff + n * 2048 + k * 1024); } while (0)
#define PG8_MMA(ai, bj, At, Bt) do { __builtin_amdgcn_s_setprio(1); _Pragma("unroll") for (int m = 0; m < 4; ++m) _Pragma("unroll") for (int n = 0; n < 2; ++n) _Pragma("unroll") for (int k = 0; k < 2; ++k) \
        acc[ai][bj][m][n] = __builtin_amdgcn_mfma_f32_16x16x32_bf16(Bt[n][k], At[m][k], acc[ai][bj][m][n], 0, 0, 0); __builtin_amdgcn_s_setprio(0); } while (0)
#define PG8_WAIT_V(n) asm volatile("s_waitcnt vmcnt(" #n ")" ::: "memory")
#define PG8_WAIT_L(n) asm volatile("s_waitcnt lgkmcnt(" #n ")" ::: "memory")
#define PG8_BAR __builtin_amdgcn_s_barrier()
#define PG8_SCHED __builtin_amdgcn_sched_barrier(0)
    Unit cur, nxt; int ui = 0;
    if (!S.next(0, cur)) return;
    f32x4 acc[2][2][4][2];
#pragma unroll
    for (int a = 0; a < 2; ++a)
#pragma unroll
        for (int b = 0; b < 2; ++b)
#pragma unroll
            for (int m = 0; m < 4; ++m)
#pragma unroll
                for (int n = 0; n < 2; ++n) acc[a][b][m][n] = (f32x4){0.f, 0.f, 0.f, 0.f};
    bf16x8 At[4][2], B0[2][2], B1[2][2];
    const char* cA = (const char*)g.A + (size_t)cur.pm * tstep; const char* cB = (const char*)g.Bt + (size_t)cur.pn * tstep;
    S.a_ready(cur);
    if constexpr (SP2) {
        PG8_STAGE(PG8_SB(0, 0), cB, voffB); PG8_STAGE(PG8_SB(0, 1), cB + hstep, voffB); PG8_STAGE(PG8_SA(0, 0), cA, voffA); PG8_STAGE(PG8_SA(0, 1), cA + hstep, voffA);
        if (wr == 1) PG8_BAR;
        PG8_WAIT_V(2); PG8_BAR;
        PG8_STAGE(PG8_SB(1, 0), cB + kstep, voffB); PG8_STAGE(PG8_SA(1, 0), cA + kstep, voffA); PG8_STAGE(PG8_SB(1, 1), cB + hstep + kstep, voffB);
        PG8_WAIT_V(6); PG8_BAR;
    } else {
        PG8_STAGE(PG8_SB(0, 0), cB, voffB); PG8_STAGE(PG8_SA(0, 0), cA, voffA); PG8_STAGE(PG8_SB(0, 1), cB + hstep, voffB); PG8_STAGE(PG8_SA(0, 1), cA + hstep, voffA);
        if (wr == 1) PG8_BAR;
        PG8_WAIT_V(4); PG8_BAR;
        PG8_STAGE(PG8_SB(1, 0), cB + kstep, voffB); PG8_STAGE(PG8_SA(1, 0), cA + kstep, voffA); PG8_STAGE(PG8_SB(1, 1), cB + hstep + kstep, voffB);
        PG8_WAIT_V(6); PG8_BAR;
    }
    for (;;) {
        const bool has_next = S.next(ui + 1, nxt);
        const char* nA = has_next ? (const char*)g.A + (size_t)nxt.pm * tstep : cA; const char* nB = has_next ? (const char*)g.Bt + (size_t)nxt.pn * tstep : cB;
        for (int t = 0; t < nt; t += 2) {
            const bool last = (t == nt - 2);
            const char* a1 = cA + (size_t)(t + 1) * kstep;
            const char* a2 = last ? nA : cA + (size_t)(t + 2) * kstep; const char* b2 = last ? nB : cB + (size_t)(t + 2) * kstep;
            const char* a3 = a2 + kstep; const char* b3 = b2 + kstep;
            if (last && has_next) S.a_ready(nxt);
            if constexpr (SP2) {
            PG8_LDB(B0, 0, 0); PG8_LDB(B1, 0, 1); PG8_SCHED; PG8_LDA(At, 0, 0); PG8_STAGE(PG8_SA(1, 1), a1 + hstep, voffA);
            PG8_WAIT_V(8); PG8_WAIT_L(0); PG8_BAR; PG8_MMA(0, 0, At, B0); PG8_MMA(0, 1, At, B1); PG8_BAR; PG8_SCHED;
            PG8_LDA(At, 0, 1); PG8_STAGE(PG8_SB(0, 0), b2, voffB); PG8_STAGE(PG8_SB(0, 1), b2 + hstep, voffB); PG8_STAGE(PG8_SA(0, 0), a2, voffA);
            PG8_WAIT_V(8); PG8_WAIT_L(0); PG8_BAR; PG8_MMA(1, 0, At, B0); PG8_MMA(1, 1, At, B1); PG8_BAR; PG8_SCHED;
            PG8_LDB(B0, 1, 0); PG8_LDB(B1, 1, 1); PG8_SCHED; PG8_LDA(At, 1, 0); PG8_STAGE(PG8_SA(0, 1), a2 + hstep, voffA);
            PG8_WAIT_V(8); PG8_WAIT_L(0); PG8_BAR; PG8_MMA(0, 0, At, B0); PG8_MMA(0, 1, At, B1); PG8_BAR; PG8_SCHED;
            PG8_LDA(At, 1, 1); PG8_STAGE(PG8_SB(1, 0), b3, voffB); PG8_STAGE(PG8_SB(1, 1), b3 + hstep, voffB); PG8_STAGE(PG8_SA(1, 0), a3, voffA);
            PG8_WAIT_V(8); PG8_WAIT_L(0); PG8_BAR; PG8_MMA(1, 0, At, B0); PG8_MMA(1, 1, At, B1); PG8_BAR; PG8_SCHED;
            } else {
            PG8_LDB(B0, 0, 0); PG8_SCHED; PG8_LDA(At, 0, 0); PG8_STAGE(PG8_SA(1, 1), a1 + hstep, voffA);
            PG8_WAIT_L(8); PG8_BAR; PG8_WAIT_L(0); PG8_MMA(0, 0, At, B0); PG8_BAR; PG8_SCHED;
            PG8_LDB(B1, 0, 1); PG8_STAGE(PG8_SB(0, 0), b2, voffB);
            PG8_BAR; PG8_WAIT_L(0); PG8_MMA(0, 1, At, B1); PG8_BAR;
            PG8_LDA(At, 0, 1); PG8_STAGE(PG8_SA(0, 0), a2, voffA);
            PG8_BAR; PG8_WAIT_L(0); PG8_MMA(1, 0, At, B0); PG8_BAR; PG8_SCHED;
            PG8_STAGE(PG8_SB(0, 1), b2 + hstep, voffB);
            PG8_WAIT_V(6); PG8_BAR; PG8_MMA(1, 1, At, B1); PG8_BAR;
            PG8_LDB(B0, 1, 0); PG8_SCHED; PG8_LDA(At, 1, 0); PG8_STAGE(PG8_SA(0, 1), a2 + hstep, voffA);
            PG8_WAIT_L(8); PG8_BAR; PG8_WAIT_L(0); PG8_MMA(0, 0, At, B0); PG8_BAR; PG8_SCHED;
            PG8_LDB(B1, 1, 1); PG8_STAGE(PG8_SB(1, 0), b3, voffB);
            PG8_BAR; PG8_WAIT_L(0); PG8_MMA(0, 1, At, B1); PG8_BAR;
            PG8_LDA(At, 1, 1); PG8_STAGE(PG8_SA(1, 0), a3, voffA);
            PG8_BAR; PG8_WAIT_L(0); PG8_MMA(1, 0, At, B0); PG8_BAR; PG8_SCHED;
            PG8_STAGE(PG8_SB(1, 1), b3 + hstep, voffB);
            PG8_WAIT_V(6); PG8_BAR; PG8_MMA(1, 1, At, B1); PG8_BAR;
            }
        }
        if constexpr (ALIGN_EPI) { if (wr == 0) PG8_BAR; }
        if (!E.after_drain()) { E(acc, cur, wr, wc, fr, fq); S.done(cur); }
        if (!has_next) break;
#pragma unroll
        for (int a = 0; a < 2; ++a)
#pragma unroll
            for (int b = 0; b < 2; ++b)
#pragma unroll
                for (int m = 0; m < 4; ++m)
#pragma unroll
                    for (int n = 0; n < 2; ++n) acc[a][b][m][n] = (f32x4){0.f, 0.f, 0.f, 0.f};
        cur = nxt; cA = nA; cB = nB; ++ui;
        if constexpr (ALIGN_EPI) { if (wr == 1) PG8_BAR; }
    }
    PG8_WAIT_V(0);
    if constexpr (!ALIGN_EPI) { if (wr == 0) PG8_BAR; }
    PG8_BAR;
    if (E.after_drain()) { E.fused(acc, cur, wr, wc, fr, fq, lds, wid, lane); S.done(cur); }
#undef PG8_SA
#undef PG8_SB
#undef PG8_STAGE
#undef PG8_LDA
#undef PG8_LDB
#undef PG8_MMA
#undef PG8_WAIT_V
#undef PG8_WAIT_L
#undef PG8_BAR
#undef PG8_SCHED
}
}

constexpr size_t MiB = 1u << 20;
constexpr size_t WS_FFIN = 1 * MiB;
constexpr size_t WS_FFOUT = 45 * MiB;
constexpr size_t WS_WIN = 67 * MiB;
constexpr size_t WS_WOUT = 76 * MiB;
constexpr size_t WS_MOD = 80 * MiB;
constexpr size_t WS_ROPE = 90 * MiB;
constexpr size_t WS_H = 91 * MiB;
constexpr size_t WS_ACT = 124 * MiB;
constexpr size_t WS_PROJ = 124 * MiB;
constexpr size_t WS_MIX = 198 * MiB;
constexpr size_t WS_HGS = 297 * MiB;
constexpr size_t WS_HGD = 235 * MiB;
constexpr size_t WS_YS = 236 * MiB;
constexpr size_t WS_ST = 238 * MiB;
constexpr size_t WS_XB = 240 * MiB;
constexpr size_t WS_OL = 273 * MiB;
constexpr size_t WS_QT = 289 * MiB;
constexpr size_t WS_END = 305 * MiB;
constexpr size_t O_Y = 0, O_KWIN = 16908288, O_VWIN = 16973824, O_HSP = 17039360, O_KNEW = 17104896, O_VNEW = 17137664, O_GV = 17170432, O_HSS = 17235968;

constexpr int LDS_BYTES = 147456;
constexpr int NPH = 26;

#define LAS __attribute__((address_space(3)))
typedef unsigned short bf16_t;
typedef short bf16x8 __attribute__((ext_vector_type(8)));
typedef float f32x4 __attribute__((ext_vector_type(4)));
typedef unsigned u32x4 __attribute__((ext_vector_type(4)));
typedef unsigned u32x2 __attribute__((ext_vector_type(2)));

__device__ __forceinline__ float bf2f(unsigned h) { return __uint_as_float(h << 16); }
__device__ __forceinline__ unsigned f2bf(float f) { unsigned u = __float_as_uint(f); return (u + 0x7fffu + ((u >> 16) & 1u)) >> 16; }
__device__ __forceinline__ unsigned pk2(float lo, float hi) { return f2bf(lo) | (f2bf(hi) << 16); }
__device__ __forceinline__ void unpack8(const u32x4 w, float* x) {
    x[0] = __uint_as_float(w.x << 16); x[1] = __uint_as_float(w.x & 0xffff0000u); x[2] = __uint_as_float(w.y << 16); x[3] = __uint_as_float(w.y & 0xffff0000u);
    x[4] = __uint_as_float(w.z << 16); x[5] = __uint_as_float(w.z & 0xffff0000u); x[6] = __uint_as_float(w.w << 16); x[7] = __uint_as_float(w.w & 0xffff0000u);
}
__device__ __forceinline__ u32x4 pack8(const float* x) { u32x4 w; w.x = pk2(x[0], x[1]); w.y = pk2(x[2], x[3]); w.z = pk2(x[4], x[5]); w.w = pk2(x[6], x[7]); return w; }
__device__ __forceinline__ float sigmoid_f(float x) { return 1.0f / (1.0f + __expf(-x)); }
__device__ __forceinline__ float silu2(float x) { return x * __builtin_amdgcn_rcpf(1.0f + __expf(-x)); }
__device__ __forceinline__ float wave_sum(float v) {
#pragma unroll
    for (int o = 1; o < 64; o <<= 1) v += __shfl_xor(v, o);
    return v;
}
__device__ __forceinline__ float wave_max(float v) {
#pragma unroll
    for (int o = 1; o < 64; o <<= 1) v = fmaxf(v, __shfl_xor(v, o));
    return v;
}

#define LDS_BARRIER() asm volatile("s_waitcnt lgkmcnt(0)\n\ts_barrier" ::: "memory")

struct Args { const float* in[24]; float* out; unsigned char* ws; int ph_lo, ph_hi; };

struct Ctx {
    LAS unsigned char* lds;
    int tid, lane, wave, G, bid;
    const float* const* in;
    float* out; unsigned char* ws;
};
#define IN(i) (C.in[i])
#define WSP(T, off) ((T*)(C.ws + (off)))

struct TrD { const float* src; size_t ld; bf16_t* dst; int K; };
__device__ __forceinline__ void tr_load(f32x4 (&v)[16], const TrD& d) {
#pragma unroll
    for (int i = 0; i < 16; ++i) v[i] = *(const f32x4*)(d.src + (size_t)(4 * i) * d.ld);
}
__device__ __forceinline__ void tr_finish(const f32x4 (&v)[16], const TrD& d, LAS float* scr, int lane) {
#pragma unroll
    for (int i = 0; i < 16; ++i) { LAS float* p = scr + (4 * i + (lane >> 4)) * 65 + (lane & 15) * 4; p[0] = v[i].x; p[1] = v[i].y; p[2] = v[i].z; p[3] = v[i].w; }
    asm volatile("s_waitcnt lgkmcnt(0)" ::: "memory");
    const int c = lane & 7;
#pragma unroll
    for (int j = 0; j < 8; ++j) { const int n = (lane >> 3) + 8 * j; const LAS float* s = scr + (8 * c) * 65 + n;
        u32x4 o; o.x = pk2(s[0 * 65], s[1 * 65]); o.y = pk2(s[2 * 65], s[3 * 65]); o.z = pk2(s[4 * 65], s[5 * 65]); o.w = pk2(s[6 * 65], s[7 * 65]);
        *(u32x4*)(d.dst + (size_t)n * d.K + 8 * c) = o; }
    asm volatile("s_waitcnt lgkmcnt(0)" ::: "memory");
}
constexpr int N_TR_LAYER = 2 * 16 * 88 + 2 * 44 * 16 + 16 * 36 + 16 * 16;
__device__ __forceinline__ TrD tr_desc(const Ctx& C, int l, int it) {
    constexpr int I_FI = 16 * 88, I_FO = 44 * 16, I_WI = 16 * 36;
    const float* W; bf16_t* WT; int K, N, k0, n0, drow;
    int r = it;
    if (r < 2 * I_FI) { const int f = r / I_FI, q = r % I_FI, mi = l * 2 + f; const int kb = q / 88, nb = q % 88; n0 = nb * 64;
        const int half = n0 >= DFF ? 1 : 0, j0 = n0 - half * DFF; drow = 256 * (j0 >> 7) + 128 * half + (j0 & 127);
        W = IN(f ? 18 : 16) + (size_t)l * DM * 2 * DFF; K = DM; N = 2 * DFF; WT = WSP(bf16_t, WS_FFIN) + (size_t)mi * 2 * DFF * DM; k0 = kb * 64; }
    else if (r < 2 * I_FI + 2 * I_FO) { r -= 2 * I_FI; const int f = r / I_FO, q = r % I_FO, mi = l * 2 + f; const int kb = q / 16, nb = q % 16;
        W = IN(f ? 19 : 17) + (size_t)l * DFF * DM; K = DFF; N = DM; WT = WSP(bf16_t, WS_FFOUT) + (size_t)mi * DM * DFF; k0 = kb * 64; n0 = nb * 64; drow = n0; }
    else if (r < 2 * I_FI + 2 * I_FO + I_WI) { r -= 2 * I_FI + 2 * I_FO; const int kb = r / 36, nb = r % 36;
        W = IN(7) + (size_t)l * DM * DIN; K = DM; N = DIN; WT = WSP(bf16_t, WS_WIN) + (size_t)l * DIN * DM; k0 = kb * 64; n0 = nb * 64; drow = n0; }
    else { r -= 2 * I_FI + 2 * I_FO + I_WI; const int kb = r / 16, nb = r % 16;
        W = IN(8) + (size_t)l * DM * DM; K = DM; N = DM; WT = WSP(bf16_t, WS_WOUT) + (size_t)l * DM * DM; k0 = kb * 64; n0 = nb * 64; drow = n0; }
    TrD d; d.src = W + (size_t)(k0 + (C.lane >> 4)) * N + n0 + (C.lane & 15) * 4; d.ld = (size_t)N; d.dst = WT + (size_t)drow * K + k0; d.K = K;
    return d;
}
__device__ __forceinline__ void ada_item(const Ctx& C, int item) {
    LAS bf16_t* As = (LAS bf16_t*)C.lds;
    const int l = item / 72, n0 = (item % 72) * 128 + C.wave * 16, lane = C.lane, fr = lane & 15, fq = lane >> 4;
    const float* W = IN(20) + (size_t)l * DM * MODW + n0 + fr;
    f32x4 acc[9];
#pragma unroll
    for (int i = 0; i < 9; ++i) acc[i] = (f32x4){0.f, 0.f, 0.f, 0.f};
#pragma unroll 1
    for (int kc = 0; kc < 4; ++kc) {
        __syncthreads();
        for (int e = C.tid; e < 144 * 32; e += 512) { const int r = e >> 5, k8 = (e & 31) * 8; u32x4 w = (u32x4){0u, 0u, 0u, 0u};
            if (r < NCROW) { const float* cp = (r < 2 ? IN(5) + (size_t)r * DM : IN(6) + (size_t)(r - 2) * DM) + kc * 256 + k8;
                const f32x4 a = *(const f32x4*)cp, b = *(const f32x4*)(cp + 4);
                w.x = pk2(silu2(a.x), silu2(a.y)); w.y = pk2(silu2(a.z), silu2(a.w)); w.z = pk2(silu2(b.x), silu2(b.y)); w.w = pk2(silu2(b.z), silu2(b.w)); }
            *(LAS u32x4*)(As + r * 264 + k8) = w; }
        __syncthreads();
        const float* Wk = W + (size_t)(kc * 256 + fq * 8) * MODW;
#pragma unroll 4
        for (int ks = 0; ks < 8; ++ks) {
            float bv[8];
#pragma unroll
            for (int j = 0; j < 8; ++j) bv[j] = Wk[(size_t)(ks * 32 + j) * MODW];
            const bf16x8 bf = __builtin_bit_cast(bf16x8, pack8(bv));
#pragma unroll
            for (int mt = 0; mt < 9; ++mt) { const bf16x8 av = *(const LAS bf16x8*)(As + (mt * 16 + fr) * 264 + ks * 32 + fq * 8);
                acc[mt] = __builtin_amdgcn_mfma_f32_16x16x32_bf16(av, bf, acc[mt], 0, 0, 0); }
        }
    }
    const float bias = IN(21)[l * MODW + n0 + fr];
    float* mo = WSP(float, WS_MOD) + (size_t)l * NCROW * MODW + n0 + fr;
#pragma unroll
    for (int mt = 0; mt < 9; ++mt)
#pragma unroll
        for (int i = 0; i < 4; ++i) { const int r = mt * 16 + fq * 4 + i; if (r < NCROW) mo[(size_t)r * MODW] = acc[mt][i] + bias; }
}
__device__ __forceinline__ void phase_prologue(const Ctx& C, int rep = 0) {
    {
        float* rt = WSP(float, WS_ROPE);
        for (int e = C.bid * 512 + C.tid; e < 8193 * 8; e += C.G * 512) {
            const int p = e >> 3, i = e & 7; const int pos = (p == 8192) ? 16384 : p;
            const float invf = exp2f(-(float)i * 2.3664460711655217f);
            const double rev = (double)pos * (double)invf * 0.15915494309189535;
            const float r = (float)((rev - rint(rev)) * 6.283185307179586);
            rt[p * 16 + i] = __cosf(r); rt[p * 16 + 8 + i] = __sinf(r);
        }
    }
    unsigned* ctr = WSP(unsigned, 0) + rep * 64;
    volatile LAS int* sitem = (volatile LAS int*)(C.lds + LDS_BYTES - 16);
    constexpr int N_ITEMS = 144 + 2 * (N_TR_LAYER / 8);
#define Q_FETCH(var) do { LDS_BARRIER(); if (C.tid == 0) *sitem = (int)atomicAdd(ctr, 1u); LDS_BARRIER(); var = *sitem; } while (0)
#define Q_DESC(it_) tr_desc(C, ((it_) - 144) / (N_TR_LAYER / 8), (((it_) - 144) % (N_TR_LAYER / 8)) * 8 + C.wave)
    int it; Q_FETCH(it);
    while (it < 144) { ada_item(C, it); Q_FETCH(it); }
    LAS float* scr = (LAS float*)(C.lds + C.wave * 16640);
    f32x4 va[16], vb[16]; TrD da, db;
    if (it < N_ITEMS) { da = Q_DESC(it); tr_load(va, da); }
    while (it < N_ITEMS) {
        int nxt; Q_FETCH(nxt);
        if (nxt < N_ITEMS) { db = Q_DESC(nxt); tr_load(vb, db); }
        tr_finish(va, da, scr, C.lane);
        it = nxt; if (it >= N_ITEMS) break;
        Q_FETCH(nxt);
        if (nxt < N_ITEMS) { da = Q_DESC(nxt); tr_load(va, da); }
        tr_finish(vb, db, scr, C.lane);
        it = nxt;
    }
#undef Q_FETCH
#undef Q_DESC
}

__device__ __forceinline__ void phase_mod0(const Ctx& C) {
    const int gw = C.bid * 8 + C.wave, NGW = C.G * 8;
    const float* mod = WSP(float, WS_MOD);
#define ROWSRC(r) ((r) < MP ? IN(0) + (size_t)(r) * DM : IN(1) + (size_t)((r) - MP) * DM)
    f32x4 nx[4];
    if (gw < MR) { const float* xs = ROWSRC(gw);
#pragma unroll
        for (int j = 0; j < 4; ++j) nx[j] = *(const f32x4*)(xs + 4 * C.lane + 256 * j); }
    for (int r = gw; r < MR; r += NGW) {
        f32x4 x[4];
#pragma unroll
        for (int j = 0; j < 4; ++j) x[j] = nx[j];
        const int rn = r + NGW;
        if (rn < MR) { const float* xs = ROWSRC(rn);
#pragma unroll
            for (int j = 0; j < 4; ++j) nx[j] = *(const f32x4*)(xs + 4 * C.lane + 256 * j); }
        const float* mp = mod + (size_t)crow_of(r) * MODW;
        bf16_t* ho = WSP(bf16_t, WS_H) + (size_t)r * DM;
#pragma unroll
        for (int j = 0; j < 4; ++j) { const int c = 4 * C.lane + 256 * j;
            const f32x4 sh = *(const f32x4*)(mp + c), sc = *(const f32x4*)(mp + DM + c);
            const f32x4 h = x[j] * (sc + 1.0f) + sh;
            u32x2 w; w.x = pk2(h.x, h.y); w.y = pk2(h.z, h.w); *(u32x2*)(ho + c) = w; }
    }
#undef ROWSRC
}

__device__ __forceinline__ void ln_finish(const Ctx& C, int r, float (&v)[2][8], const f32x4 (&gv)[2][2], const f32x4 (&bv)[2][2], const float* mp, bool last, float* ST) {
    float s = 0.f;
#pragma unroll
    for (int j = 0; j < 2; ++j)
#pragma unroll
        for (int e = 0; e < 8; ++e) s += v[j][e];
    const float mean = wave_sum(s) * (1.0f / DM); float s2 = 0.f;
#pragma unroll
    for (int j = 0; j < 2; ++j)
#pragma unroll
        for (int e = 0; e < 8; ++e) { v[j][e] -= mean; s2 += v[j][e] * v[j][e]; }
    const float rstd = 1.0f / sqrtf(wave_sum(s2) * (1.0f / DM) + 1e-5f);
    if (!last && C.lane == 0) { ST[2 * r] = mean; ST[2 * r + 1] = rstd; }
#pragma unroll
    for (int j = 0; j < 2; ++j) { const int c = 8 * C.lane + 512 * j;
        float y[8];
#pragma unroll
        for (int e = 0; e < 8; ++e) y[e] = v[j][e] * rstd * gv[j][e >> 2][e & 3] + bv[j][e >> 2][e & 3];
        if (last) { float* yo = C.out + (size_t)r * DM + c; *(f32x4*)yo = (f32x4){y[0], y[1], y[2], y[3]}; *(f32x4*)(yo + 4) = (f32x4){y[4], y[5], y[6], y[7]}; }
        else { const f32x4 sh0 = *(const f32x4*)(mp + c), sh1 = *(const f32x4*)(mp + c + 4), sc0 = *(const f32x4*)(mp + DM + c), sc1 = *(const f32x4*)(mp + DM + c + 4);
            float h[8];
#pragma unroll
            for (int e = 0; e < 8; ++e) h[e] = y[e] * ((e < 4 ? sc0[e & 3] : sc1[e & 3]) + 1.0f) + (e < 4 ? sh0[e & 3] : sh1[e & 3]);
            *(u32x4*)(WSP(bf16_t, WS_H) + (size_t)r * DM + c) = pack8(h); }
    }
}
__device__ __forceinline__ void phase_ln(const Ctx& C, int l, int which, int rep = 0) {
    const int gw = C.bid * 8 + C.wave, NGW = C.G * 8;
    const int li = l * 3 + which;
    const float* g = IN(22) + (size_t)li * DM; const float* bb = IN(23) + (size_t)li * DM;
    const bool has_prev = (li > 0), last = (li == 3 * DEPTH - 1);
    const float* pg = IN(22) + (size_t)(has_prev ? li - 1 : 0) * DM; const float* pb = IN(23) + (size_t)(has_prev ? li - 1 : 0) * DM;
    int ml = l, si = (which == 0) ? 3 : 6;
    if (which == 2) { ml = l + 1; si = 0; }
    const float* mod = WSP(float, WS_MOD) + (size_t)(last ? 0 : ml) * NCROW * MODW + (size_t)si * DM;
    const float* gatep = WSP(float, WS_MOD) + (size_t)l * NCROW * MODW + (size_t)(which == 0 ? 2 : which == 1 ? 5 : 8) * DM;
    const float rscale = (which == 1) ? 1.0f : 0.5f;
    float* ST = WSP(float, WS_ST);
    bf16_t* XB = WSP(bf16_t, WS_XB);
    f32x4 gv[2][2], bv[2][2];
#pragma unroll
    for (int j = 0; j < 2; ++j)
#pragma unroll
        for (int q = 0; q < 2; ++q) { gv[j][q] = *(const f32x4*)(g + 8 * C.lane + 512 * j + 4 * q); bv[j][q] = *(const f32x4*)(bb + 8 * C.lane + 512 * j + 4 * q); }
    {
        u32x4 nv[2];
        if (gw < MP) { nv[0] = *(const u32x4*)(XB + (size_t)gw * DM + 8 * C.lane); nv[1] = *(const u32x4*)(XB + (size_t)gw * DM + 8 * C.lane + 512); }
        for (int r = gw; r < MP; r += NGW) {
            float v[2][8]; unpack8(nv[0], v[0]); unpack8(nv[1], v[1]);
            const int rn = r + NGW;
            if (rn < MP) { nv[0] = *(const u32x4*)(XB + (size_t)rn * DM + 8 * C.lane); nv[1] = *(const u32x4*)(XB + (size_t)rn * DM + 8 * C.lane + 512); }
            ln_finish(C, r, v, gv, bv, mod + (size_t)(r >> 13) * MODW, last, ST);
        }
    }
    for (int r = MP + gw; r < MR && rep == 0; r += NGW) {
        float v[2][8];
        float pm = 0.f, pr = 1.f; if (has_prev) { pm = ST[2 * r]; pr = ST[2 * r + 1]; }
        const float* ys = WSP(float, WS_YS) + (size_t)(r - MP) * DM; const float* gp = gatep + (size_t)crow_of(r) * MODW;
#pragma unroll
        for (int j = 0; j < 2; ++j) { const int c = 8 * C.lane + 512 * j;
            float x[8];
            if (has_prev) { unpack8(*(const u32x4*)(XB + (size_t)r * DM + c), x);
#pragma unroll
                for (int e = 0; e < 8; ++e) x[e] = (x[e] - pm) * pr * pg[c + e] + pb[c + e]; }
            else { const float* xs = IN(1) + (size_t)(r - MP) * DM + c;
#pragma unroll
                for (int e = 0; e < 8; ++e) x[e] = xs[e]; }
#pragma unroll
            for (int e = 0; e < 8; ++e) { const float y = (ys[c + e] + ys[131072 + c + e]) + (ys[262144 + c + e] + ys[393216 + c + e]);
                v[j][e] = x[e] * ALPHA_F + (gp[c + e] + 1.0f) * (y * rscale); }
            if (!last) { const u32x4 w = pack8(v[j]); *(u32x4*)(XB + (size_t)r * DM + c) = w; unpack8(w, v[j]); }
        }
        ln_finish(C, r, v, gv, bv, mod + (size_t)crow_of(r) * MODW, last, ST);
    }
}

__device__ __forceinline__ int vperm(int key) { return (key & ~31) | (((key >> 2) & 3) << 3) | (((key >> 4) & 1) << 2) | (key & 3); }
__device__ __forceinline__ void attn_prompt_item(const Ctx& C, int l, int item) {
    const int b = item >> 7, blk = (item >> 1) & 63, kvh = item & 1;
    LAS bf16_t* Ks = (LAS bf16_t*)C.lds;
    LAS bf16_t* Vt = (LAS bf16_t*)(C.lds + 36864);
    const bf16_t* P = WSP(bf16_t, WS_PROJ) + (size_t)b * SEQ * DIN;
    const float* rope = WSP(float, WS_ROPE);
    u32x4 qpre0[4], qpre1[4]; f32x4 rcs[4][4];
    {   const int fr_ = C.lane & 15, fq_ = C.lane >> 4, hq_ = kvh * 4 + (C.wave >> 1);
#pragma unroll
        for (int st = 0; st < 4; ++st) { const int t_ = blk * 128 + ((C.wave & 1) * 4 + st) * 16 + fr_; const bf16_t* qp = P + (size_t)t_ * DIN + hq_ * 64;
            qpre0[st] = *(const u32x4*)(qp + fq_ * 8); qpre1[st] = *(const u32x4*)(qp + 32 + fq_ * 8);
            const float* rr = rope + (size_t)t_ * 16; rcs[st][0] = *(const f32x4*)rr; rcs[st][1] = *(const f32x4*)(rr + 4); rcs[st][2] = *(const f32x4*)(rr + 8); rcs[st][3] = *(const f32x4*)(rr + 12); } }
    __syncthreads();
    {
        const int seg = C.tid & 7, key0 = C.tid >> 3;
#pragma unroll 1
        for (int hb = 0; hb < 2; ++hb) {
            u32x4 kwv[2], vwv[2], owv[2]; f32x4 rc[2][4];
#pragma unroll
            for (int j = 0; j < 2; ++j) { const int key = key0 + 64 * (2 * hb + j), t = (blk - 1) * 128 + key;
                kwv[j] = (u32x4){0u, 0u, 0u, 0u}; vwv[j] = kwv[j]; owv[j] = kwv[j];
#pragma unroll
                for (int q = 0; q < 4; ++q) rc[j][q] = (f32x4){0.f, 0.f, 0.f, 0.f};
                if (t >= 0) { const bf16_t* rp = P + (size_t)t * DIN;
                    kwv[j] = *(const u32x4*)(rp + 512 + kvh * 64 + seg * 8); vwv[j] = *(const u32x4*)(rp + 640 + kvh * 64 + seg * 8);
                    if (seg < 2) { owv[j] = *(const u32x4*)(rp + 512 + kvh * 64 + (seg ^ 1) * 8); const float* rr = rope + (size_t)t * 16;
                        rc[j][0] = *(const f32x4*)rr; rc[j][1] = *(const f32x4*)(rr + 4); rc[j][2] = *(const f32x4*)(rr + 8); rc[j][3] = *(const f32x4*)(rr + 12); } } }
#pragma unroll
            for (int j = 0; j < 2; ++j) { const int key = key0 + 64 * (2 * hb + j);
                u32x4 kw = kwv[j]; float kf[8], vf[8];
                if (seg < 2) { float of[8]; unpack8(kw, kf); unpack8(owv[j], of);
#pragma unroll
                    for (int e = 0; e < 8; ++e) { const float cs = rc[j][e >> 2][e & 3], sn = rc[j][2 + (e >> 2)][e & 3]; kf[e] = (seg == 0) ? (kf[e] * cs - of[e] * sn) : (kf[e] * cs + of[e] * sn); }
                    kw = pack8(kf); }
                *(LAS u32x4*)(Ks + key * 72 + seg * 8) = kw;
                unpack8(vwv[j], vf);
                const int pk = vperm(key);
#pragma unroll
                for (int e = 0; e < 8; ++e) Vt[(seg * 8 + e) * 264 + pk] = (bf16_t)(__float_as_uint(vf[e]) >> 16);
                if (blk == 63 && key >= 128) {
                    unpack8(kw, kf);
                    const size_t o = ((size_t)((l * 2 + b) * 128 + (key - 128)) * 2 + kvh) * 64 + seg * 8;
                    *(f32x4*)(C.out + O_KWIN + o) = (f32x4){kf[0], kf[1], kf[2], kf[3]}; *(f32x4*)(C.out + O_KWIN + o + 4) = (f32x4){kf[4], kf[5], kf[6], kf[7]};
                    *(f32x4*)(C.out + O_VWIN + o) = (f32x4){vf[0], vf[1], vf[2], vf[3]}; *(f32x4*)(C.out + O_VWIN + o + 4) = (f32x4){vf[4], vf[5], vf[6], vf[7]};
                }
            }
        }
    }
    __syncthreads();
    const int w = C.wave, lane = C.lane, fr = lane & 15, fq = lane >> 4;
    const int hq = kvh * 4 + (w >> 1);
    const float sink = IN(9)[l * 8 + hq];
    bf16_t* MIX = WSP(bf16_t, WS_MIX) + (size_t)b * SEQ * DM;
#pragma unroll
    for (int st = 0; st < 4; ++st) {
        const int isub = (w & 1) * 4 + st; const int t = blk * 128 + isub * 16 + fr;
        u32x4 q0w = qpre0[st]; const u32x4 q1w = qpre1[st];
        {
            float x[8], o[8]; unpack8(q0w, x);
#pragma unroll
            for (int e = 0; e < 8; ++e) o[e] = __shfl_xor(x[e], 16);
            if (fq < 2) {
#pragma unroll
                for (int e = 0; e < 8; ++e) { const float cs = rcs[st][e >> 2][e & 3], sn = rcs[st][2 + (e >> 2)][e & 3]; x[e] = (fq == 0) ? (x[e] * cs - o[e] * sn) : (x[e] * cs + o[e] * sn); }
                q0w = pack8(x);
            }
        }
        const bf16x8 q0 = __builtin_bit_cast(bf16x8, q0w), q1 = __builtin_bit_cast(bf16x8, q1w);
        const int kbase = 32 * (isub >> 1);
        f32x4 s[10];
#pragma unroll
        for (int j = 0; j < 10; ++j) {
            const LAS bf16_t* kp = Ks + (kbase + 16 * j + fr) * 72 + fq * 8;
            const bf16x8 a0 = *(const LAS bf16x8*)kp, a1 = *(const LAS bf16x8*)(kp + 32);
            f32x4 z = (f32x4){0.f, 0.f, 0.f, 0.f};
            z = __builtin_amdgcn_mfma_f32_16x16x32_bf16(a0, q0, z, 0, 0, 0);
            s[j] = __builtin_amdgcn_mfma_f32_16x16x32_bf16(a1, q1, z, 0, 0, 0);
        }
        const int qi = 128 + isub * 16 + fr;
        float mx = sink;
#pragma unroll
        for (int j = 0; j < 10; ++j)
#pragma unroll
            for (int i = 0; i < 4; ++i) { const int kj = kbase + 16 * j + 4 * fq + i;
                const bool valid = (kj <= qi) && (qi - kj < 128) && (blk > 0 || kj >= 128);
                const float v = valid ? s[j][i] * 0.125f : -1e30f; s[j][i] = v; mx = fmaxf(mx, v); }
        mx = fmaxf(mx, __shfl_xor(mx, 16)); mx = fmaxf(mx, __shfl_xor(mx, 32));
        float sum = 0.f;
#pragma unroll
        for (int j = 0; j < 10; ++j)
#pragma unroll
            for (int i = 0; i < 4; ++i) { const float p = __expf(s[j][i] - mx); s[j][i] = p; sum += p; }
        sum += __shfl_xor(sum, 16); sum += __shfl_xor(sum, 32); sum += __expf(sink - mx);
        const float rl = 1.0f / sum;
        f32x4 o[4];
#pragma unroll
        for (int dt = 0; dt < 4; ++dt) o[dt] = (f32x4){0.f, 0.f, 0.f, 0.f};
#pragma unroll
        for (int g = 0; g < 5; ++g) {
            u32x4 pw; pw.x = pk2(s[2 * g][0], s[2 * g][1]); pw.y = pk2(s[2 * g][2], s[2 * g][3]); pw.z = pk2(s[2 * g + 1][0], s[2 * g + 1][1]); pw.w = pk2(s[2 * g + 1][2], s[2 * g + 1][3]);
            const bf16x8 pb = __builtin_bit_cast(bf16x8, pw);
#pragma unroll
            for (int dt = 0; dt < 4; ++dt) {
                const bf16x8 av = *(const LAS bf16x8*)(Vt + (dt * 16 + fr) * 264 + kbase + 32 * g + fq * 8);
                o[dt] = __builtin_amdgcn_mfma_f32_16x16x32_bf16(av, pb, o[dt], 0, 0, 0);
            }
        }
        bf16_t* op = MIX + (size_t)t * DM + hq * 64 + 4 * fq;
#pragma unroll
        for (int dt = 0; dt < 4; ++dt) { u32x2 wv; wv.x = pk2(o[dt][0] * rl, o[dt][1] * rl); wv.y = pk2(o[dt][2] * rl, o[dt][3] * rl); *(u32x2*)(op + dt * 16) = wv; }
    }
}

__device__ __forceinline__ float hgrn_lb(const Ctx& C, int l, int j) { return l == 0 ? 0.f : sigmoid_f(IN(14)[256 + j] - IN(14)[j]); }
typedef float f32x2 __attribute__((ext_vector_type(2)));
__device__ __forceinline__ void hgrn_local_item(const Ctx& C, int l, int pair, int xmode = 0) {
    const int hi = C.tid >> 8, tl = C.tid & 255, wl = (C.tid >> 6) & 3;
    const int chain = pair >> 5, chunk = (pair & 31) * 2 + hi, b = chain >> 2, h = chain & 3, t0 = chunk * 128;
    LAS float* base = (LAS float*)C.lds + hi * 12288;
    LAS float* Fs = base; LAS float* Qt = base + 1024; LAS float* Is = base + 2048; LAS float* Qs = base + 3072; LAS float* Ob = base + 4096;
    const int lane = C.lane, kg = lane >> 3, vp = lane & 7, v0 = 16 * wl + 2 * vp;
    float* HS = WSP(float, WS_HGS) + (size_t)(chain * 64 + chunk) * 4096;
    f32x2 Sa[4], Sb2[4], D2[4];
#pragma unroll
    for (int j = 0; j < 4; ++j) { Sa[j] = (f32x2){0.f, 0.f}; Sb2[j] = (f32x2){0.f, 0.f}; D2[j] = (f32x2){1.f, 1.f}; }
    const int tt = tl >> 4, c4 = (tl & 15) * 4;
    f32x4 lbv;
    lbv.x = hgrn_lb(C, l, h * 64 + c4); lbv.y = hgrn_lb(C, l, h * 64 + c4 + 1); lbv.z = hgrn_lb(C, l, h * 64 + c4 + 2); lbv.w = hgrn_lb(C, l, h * 64 + c4 + 3);
    const bf16_t* P = WSP(bf16_t, WS_PROJ) + (size_t)(b * SEQ + t0) * DIN + h * 64 + c4;
    const bool qwriter = (wl == 0 && vp == 0);
    u32x2 pf, pi, pq;
    { const bf16_t* rp = P + (size_t)tt * DIN; pf = *(const u32x2*)(rp + 1536); pi = *(const u32x2*)(rp + 1792); pq = *(const u32x2*)(rp + 1280); }
#define HG_FLUSH(sub_) do { const size_t row = (size_t)(b * SEQ + t0 + (sub_) * 16 + tt); float o0 = 0.f, o1 = 0.f, o2 = 0.f, o3 = 0.f; \
        const LAS float* p0 = Ob + tt * 512 + c4 * 8; \
        _Pragma("unroll") for (int i = 0; i < 8; ++i) { const int c = (i + tl) & 7; const f32x4 pv = *(const LAS f32x4*)(p0 + c * 4); const float sv = (pv.x + pv.y) + (pv.z + pv.w); const int e = c >> 1; \
            o0 += (e == 0) ? sv : 0.f; o1 += (e == 1) ? sv : 0.f; o2 += (e == 2) ? sv : 0.f; o3 += (e == 3) ? sv : 0.f; } \
        *(f32x4*)(WSP(float, WS_OL) + row * 256 + h * 64 + c4) = (f32x4){o0, o1, o2, o3}; \
        const f32x4 qd = *(const LAS f32x4*)(Qt + tt * 64 + c4); u32x2 qw; qw.x = pk2(qd.x, qd.y); qw.y = pk2(qd.z, qd.w); \
        *(u32x2*)(WSP(bf16_t, WS_QT) + row * 256 + h * 64 + c4) = qw; } while (0)
#pragma unroll 1
    for (int sub = 0; sub < 8; ++sub) {
        LDS_BARRIER();
        const u32x2 cpf = pf, cpi = pi, cpq = pq;
        if (sub < 7) { const bf16_t* rp = P + (size_t)((sub + 1) * 16 + tt) * DIN; pf = *(const u32x2*)(rp + 1536); pi = *(const u32x2*)(rp + 1792); pq = *(const u32x2*)(rp + 1280); }
        if (sub > 0 && xmode == 0) HG_FLUSH(sub - 1);
        {
            const float cf[4] = {bf2f(cpf.x & 0xffffu), bf2f(cpf.x >> 16), bf2f(cpf.y & 0xffffu), bf2f(cpf.y >> 16)};
            f32x4 f;
            f.x = lbv.x + (1.0f - lbv.x) * __builtin_amdgcn_rcpf(1.0f + __expf(-cf[0])); f.y = lbv.y + (1.0f - lbv.y) * __builtin_amdgcn_rcpf(1.0f + __expf(-cf[1]));
            f.z = lbv.z + (1.0f - lbv.z) * __builtin_amdgcn_rcpf(1.0f + __expf(-cf[2])); f.w = lbv.w + (1.0f - lbv.w) * __builtin_amdgcn_rcpf(1.0f + __expf(-cf[3]));
            *(LAS f32x4*)(Fs + tt * 64 + c4) = f;
            *(LAS f32x4*)(Is + tt * 64 + c4) = (f32x4){bf2f(cpi.x & 0xffffu), bf2f(cpi.x >> 16), bf2f(cpi.y & 0xffffu), bf2f(cpi.y >> 16)};
            *(LAS f32x4*)(Qs + tt * 64 + c4) = (f32x4){bf2f(cpq.x & 0xffffu), bf2f(cpq.x >> 16), bf2f(cpq.y & 0xffffu), bf2f(cpq.y >> 16)};
        }
        LDS_BARRIER();
        if (xmode != 2) {
            const LAS float* fp = Fs + kg * 8; const LAS float* ip = Is + v0; const LAS float* qp = Qs + kg * 8; LAS float* op = Ob + v0 * 8 + kg; LAS float* qtp = Qt + kg * 8;
            f32x4 fa_n = *(const LAS f32x4*)fp, fb_n = *(const LAS f32x4*)(fp + 4), qa_n = *(const LAS f32x4*)qp, qb_n = *(const LAS f32x4*)(qp + 4); f32x2 iv_n = *(const LAS f32x2*)ip;
#pragma unroll
            for (int t = 0; t < 16; ++t) {
                const f32x4 fa = fa_n, fb = fb_n, qa = qa_n, qb = qb_n; const f32x2 ivv = iv_n;
                if (t < 15) { fa_n = *(const LAS f32x4*)(fp + (t + 1) * 64); fb_n = *(const LAS f32x4*)(fp + (t + 1) * 64 + 4); iv_n = *(const LAS f32x2*)(ip + (t + 1) * 64);
                    qa_n = *(const LAS f32x4*)(qp + (t + 1) * 64); qb_n = *(const LAS f32x4*)(qp + (t + 1) * 64 + 4); }
                const f32x2 ia = (f32x2){ivv.x, ivv.x}, ib = (f32x2){ivv.y, ivv.y};
                Sa[0] = ia + fa.xy * (Sa[0] - ia); Sa[1] = ia + fa.zw * (Sa[1] - ia); Sa[2] = ia + fb.xy * (Sa[2] - ia); Sa[3] = ia + fb.zw * (Sa[3] - ia);
                Sb2[0] = ib + fa.xy * (Sb2[0] - ib); Sb2[1] = ib + fa.zw * (Sb2[1] - ib); Sb2[2] = ib + fb.xy * (Sb2[2] - ib); Sb2[3] = ib + fb.zw * (Sb2[3] - ib);
                D2[0] *= fa.xy; D2[1] *= fa.zw; D2[2] *= fb.xy; D2[3] *= fb.zw;
                const f32x2 oa = qa.xy * Sa[0] + qa.zw * Sa[1] + qb.xy * Sa[2] + qb.zw * Sa[3];
                const f32x2 ob = qa.xy * Sb2[0] + qa.zw * Sb2[1] + qb.xy * Sb2[2] + qb.zw * Sb2[3];
                op[t * 512] = oa.x + oa.y; op[t * 512 + 8] = ob.x + ob.y;
                if (qwriter) { const f32x2 q0 = qa.xy * D2[0], q1 = qa.zw * D2[1], q2 = qb.xy * D2[2], q3 = qb.zw * D2[3];
                    *(LAS f32x4*)(qtp + t * 64) = (f32x4){q0.x, q0.y, q1.x, q1.y}; *(LAS f32x4*)(qtp + t * 64 + 4) = (f32x4){q2.x, q2.y, q3.x, q3.y}; }
            }
        }
    }
    LDS_BARRIER();
    if (xmode == 0) HG_FLUSH(7);
#undef HG_FLUSH
    if (xmode != 0) return;
#pragma unroll
    for (int j = 0; j < 4; ++j) { float* p0 = HS + (kg * 8 + 2 * j) * 64 + v0; *(f32x2*)p0 = (f32x2){Sa[j].x, Sb2[j].x}; *(f32x2*)(p0 + 64) = (f32x2){Sa[j].y, Sb2[j].y}; }
    if (qwriter) {
        float* HD = WSP(float, WS_HGD) + (size_t)(chain * 64 + chunk) * 64 + kg * 8;
#pragma unroll
        for (int j = 0; j < 4; ++j) { HD[2 * j] = D2[j].x; HD[2 * j + 1] = D2[j].y; }
    }
}
__device__ __forceinline__ void hgrn_corr_item(const Ctx& C, int l, int pair) {
    const int hi = C.tid >> 8, tl = C.tid & 255, wl = (C.tid >> 6) & 3;
    const int chain = pair >> 5, chunk = (pair & 31) * 2 + hi, b = chain >> 2, h = chain & 3, t0 = chunk * 128;
    LAS bf16_t* Sb = (LAS bf16_t*)C.lds + hi * (64 * 72);
    const float* HS = WSP(float, WS_HGS) + (size_t)(chain * 64 + chunk) * 4096;
    const int lane = C.lane, fr = lane & 15, fq = lane >> 4;
    const size_t row0 = (size_t)(b * SEQ + t0 + wl * 32);
    u32x4 qa[2][2];
#pragma unroll
    for (int mt = 0; mt < 2; ++mt)
#pragma unroll
        for (int ks = 0; ks < 2; ++ks) qa[mt][ks] = *(const u32x4*)(WSP(bf16_t, WS_QT) + (row0 + mt * 16 + fr) * 256 + h * 64 + ks * 32 + fq * 8);
    __syncthreads();
    if (chunk > 0) {
        const int k = tl >> 2, vb = (tl & 3) * 16;
#pragma unroll
        for (int q = 0; q < 4; ++q) { const f32x4 sv = *(const f32x4*)(HS + k * 64 + vb + 4 * q);
            Sb[(vb + 4 * q) * 72 + k] = (bf16_t)f2bf(sv.x); Sb[(vb + 4 * q + 1) * 72 + k] = (bf16_t)f2bf(sv.y); Sb[(vb + 4 * q + 2) * 72 + k] = (bf16_t)f2bf(sv.z); Sb[(vb + 4 * q + 3) * 72 + k] = (bf16_t)f2bf(sv.w); }
    }
    __syncthreads();
    f32x4 acc[2][4];
#pragma unroll
    for (int mt = 0; mt < 2; ++mt)
#pragma unroll
        for (int nt = 0; nt < 4; ++nt) acc[mt][nt] = (f32x4){0.f, 0.f, 0.f, 0.f};
    if (chunk > 0) {
#pragma unroll
        for (int nt = 0; nt < 4; ++nt)
#pragma unroll
            for (int ks = 0; ks < 2; ++ks) { const bf16x8 bv = *(const LAS bf16x8*)(Sb + (nt * 16 + fr) * 72 + ks * 32 + fq * 8);
#pragma unroll
                for (int mt = 0; mt < 2; ++mt) acc[mt][nt] = __builtin_amdgcn_mfma_f32_16x16x32_bf16(__builtin_bit_cast(bf16x8, qa[mt][ks]), bv, acc[mt][nt], 0, 0, 0); }
    }
    float gnv[4];
#pragma unroll
    for (int nt = 0; nt < 4; ++nt) gnv[nt] = IN(15)[l * 64 + nt * 16 + fr];
#pragma unroll
    for (int mt = 0; mt < 2; ++mt) {
        float ol[4][4], cg[4][4];
#pragma unroll
        for (int i = 0; i < 4; ++i) { const size_t row = row0 + mt * 16 + fq * 4 + i;
#pragma unroll
            for (int nt = 0; nt < 4; ++nt) { ol[i][nt] = WSP(float, WS_OL)[row * 256 + h * 64 + nt * 16 + fr]; cg[i][nt] = bf2f(WSP(bf16_t, WS_PROJ)[row * DIN + 2048 + h * 64 + nt * 16 + fr]); } }
#pragma unroll
        for (int i = 0; i < 4; ++i) { const size_t row = row0 + mt * 16 + fq * 4 + i;
            float o[4], ss = 0.f;
#pragma unroll
            for (int nt = 0; nt < 4; ++nt) { o[nt] = acc[mt][nt][i] + ol[i][nt]; ss += o[nt] * o[nt]; }
            ss += __shfl_xor(ss, 1); ss += __shfl_xor(ss, 2); ss += __shfl_xor(ss, 4); ss += __shfl_xor(ss, 8);
            const float r = __builtin_amdgcn_rsqf(ss * (1.0f / 64.0f) + 1e-6f);
            bf16_t* op = WSP(bf16_t, WS_MIX) + row * DM + 768 + h * 64 + fr;
#pragma unroll
            for (int nt = 0; nt < 4; ++nt) op[nt * 16] = (bf16_t)f2bf(o[nt] * r * gnv[nt] * silu2(cg[i][nt])); }
    }
}
__device__ __forceinline__ void hgrn_scan(const Ctx& C, int l) {
    for (int gid = C.bid * 512 + C.tid; gid < 131072; gid += C.G * 512) {
        const int e = gid >> 2, j = gid & 3, chain = e >> 12, kv = e & 4095, k = kv >> 6;
        float* hs = WSP(float, WS_HGS) + ((size_t)chain * 64 + 16 * j) * 4096 + kv; const float* hd = WSP(float, WS_HGD) + ((size_t)chain * 64 + 16 * j) * 64 + k;
        float vv[16], dd[16];
#pragma unroll
        for (int i = 0; i < 16; ++i) { vv[i] = hs[(size_t)i * 4096]; dd[i] = hd[i * 64]; }
        float A = 1.f, B = 0.f;
#pragma unroll
        for (int i = 0; i < 16; ++i) { B = dd[i] * B + vv[i]; A *= dd[i]; }
        float S = 0.f;
#pragma unroll
        for (int m = 0; m < 3; ++m) { const float Am = __shfl(A, (C.lane & ~3) + m), Bm = __shfl(B, (C.lane & ~3) + m); if (m < j) S = Am * S + Bm; }
#pragma unroll
        for (int i = 0; i < 16; ++i) { hs[(size_t)i * 4096] = S; S = dd[i] * S + vv[i]; }
        if (j == 3) C.out[O_HSP + (size_t)(l * 8 + chain) * 4096 + kv] = S;
    }
}

__device__ __forceinline__ void gmlp_prompt_item(const Ctx& C, int l, int item) {
    const int b = item >> 8, n = (item >> 2) & 63, g = item & 3;
    LAS bf16_t* Wb = (LAS bf16_t*)C.lds;
    LAS bf16_t* VnT = Wb + 128 * 136;
    __syncthreads();
    const float* Wg = IN(12) + (size_t)(l * 4 + g) * 128 * 128;
    const bf16_t* P = WSP(bf16_t, WS_PROJ) + (size_t)(b * SEQ + n * 128) * DIN;
    {
        f32x4 wa[4], wb[4];
#pragma unroll
        for (int i = 0; i < 4; ++i) { const int e = C.tid + 512 * i, t = e >> 4, s8 = (e & 15) * 8; wa[i] = *(const f32x4*)(Wg + t * 128 + s8); wb[i] = *(const f32x4*)(Wg + t * 128 + s8 + 4); }
        const int s = C.tid >> 2, q4 = C.tid & 3;
        const bf16_t* gp = P + (size_t)s * DIN + 1024 + q4 * 64;
        u32x4 xr[8];
#pragma unroll
        for (int i = 0; i < 8; ++i) xr[i] = *(const u32x4*)(gp + i * 8);
        const bf16_t* gg = P + (size_t)s * DIN + 1024 + g * 64 + q4 * 16;
        const u32x4 y0 = *(const u32x4*)gg, y1 = *(const u32x4*)(gg + 8);
        f32x4 lgv[4], lbv4[4];
#pragma unroll
        for (int i = 0; i < 4; ++i) { lgv[i] = *(const f32x4*)(IN(10) + l * 256 + g * 64 + q4 * 16 + 4 * i); lbv4[i] = *(const f32x4*)(IN(11) + l * 256 + g * 64 + q4 * 16 + 4 * i); }
#pragma unroll
        for (int i = 0; i < 4; ++i) { const int e = C.tid + 512 * i, t = e >> 4, s8 = (e & 15) * 8;
            float w[8] = {wa[i].x, wa[i].y, wa[i].z, wa[i].w, wb[i].x, wb[i].y, wb[i].z, wb[i].w};
#pragma unroll
            for (int j = 0; j < 8; ++j) if (s8 + j > t) w[j] = 0.f;
            *(LAS u32x4*)(Wb + t * 136 + s8) = pack8(w); }
        float sm = 0.f, sq = 0.f;
#pragma unroll
        for (int i = 0; i < 8; ++i) { float x[8]; unpack8(xr[i], x);
#pragma unroll
            for (int e = 0; e < 8; ++e) { sm += x[e]; sq += x[e] * x[e]; } }
        sm += __shfl_xor(sm, 1); sm += __shfl_xor(sm, 2); sq += __shfl_xor(sq, 1); sq += __shfl_xor(sq, 2);
        const float mean = sm * (1.0f / 256.0f);
        const float var = fmaxf(sq * (1.0f / 256.0f) - mean * mean, 0.f);
        const float rstd = 1.0f / sqrtf(var + 1e-5f);
        float x[16]; unpack8(y0, x); unpack8(y1, x + 8);
#pragma unroll
        for (int i = 0; i < 16; ++i) VnT[(q4 * 16 + i) * 136 + s] = (bf16_t)f2bf((x[i] - mean) * rstd * lgv[i >> 2][i & 3] + lbv4[i >> 2][i & 3]);
    }
    __syncthreads();
    {
        const int w = C.wave, lane = C.lane, fr = lane & 15, fq = lane >> 4;
        f32x4 acc[4];
#pragma unroll
        for (int ct = 0; ct < 4; ++ct) acc[ct] = (f32x4){0.f, 0.f, 0.f, 0.f};
        const float* bsp = IN(13) + (l * 4 + g) * 128 + w * 16 + fq * 4;
        const f32x4 bias4 = *(const f32x4*)bsp;
        bf16_t uu[4][4];
#pragma unroll
        for (int i = 0; i < 4; ++i)
#pragma unroll
            for (int ct = 0; ct < 4; ++ct) uu[i][ct] = P[(size_t)(w * 16 + fq * 4 + i) * DIN + 768 + g * 64 + fr + ct * 16];
        const int nks = (w >> 1) + 1;
        for (int ks = 0; ks < nks; ++ks) {
            const bf16x8 av = *(const LAS bf16x8*)(Wb + (w * 16 + fr) * 136 + ks * 32 + fq * 8);
#pragma unroll
            for (int ct = 0; ct < 4; ++ct) { const bf16x8 bv = *(const LAS bf16x8*)(VnT + (ct * 16 + fr) * 136 + ks * 32 + fq * 8);
                acc[ct] = __builtin_amdgcn_mfma_f32_16x16x32_bf16(av, bv, acc[ct], 0, 0, 0); }
        }
#pragma unroll
        for (int i = 0; i < 4; ++i) { const int t = w * 16 + fq * 4 + i; const float bias = bias4[i];
            bf16_t* op = WSP(bf16_t, WS_MIX) + (size_t)(b * SEQ + n * 128 + t) * DM + 512 + g * 64 + fr;
#pragma unroll
            for (int ct = 0; ct < 4; ++ct) op[ct * 16] = (bf16_t)f2bf(bf2f(uu[i][ct]) * (acc[ct][i] + bias)); }
    }
}

__device__ __forceinline__ void attn_sample_item(const Ctx& C, int l, int b) {
    const int hq = C.wave, lane = C.lane, kvh = hq >> 2;
    LAS float* qs = (LAS float*)C.lds + hq * 128; LAS float* ks = qs + 64;
    const bf16_t* rp = WSP(bf16_t, WS_PROJ) + (size_t)(MP + b) * DIN;
    const float* rr = WSP(float, WS_ROPE) + (size_t)8192 * 16;
    float qd = bf2f(rp[hq * 64 + lane]), kd = bf2f(rp[512 + kvh * 64 + lane]); const float vd = bf2f(rp[640 + kvh * 64 + lane]);
    {
        const float qo = __shfl_xor(qd, 8), ko = __shfl_xor(kd, 8);
        if (lane < 16) { const float cs = rr[lane & 7], sn = rr[8 + (lane & 7)];
            qd = (lane < 8) ? (qd * cs - qo * sn) : (qd * cs + qo * sn); kd = (lane < 8) ? (kd * cs - ko * sn) : (kd * cs + ko * sn); }
    }
    __syncthreads();
    qs[lane] = qd; ks[lane] = kd;
    if ((hq & 3) == 0) { C.out[O_KNEW + (size_t)((l * 128 + b) * 2 + kvh) * 64 + lane] = kd; C.out[O_VNEW + (size_t)((l * 128 + b) * 2 + kvh) * 64 + lane] = vd; }
    __syncthreads();
    const float* ck = IN(2) + ((size_t)(l * 128 + b) * 128 * 2 + kvh) * 64; const float* cv = IN(3) + ((size_t)(l * 128 + b) * 128 * 2 + kvh) * 64;
    float s0 = 0.f, s1 = 0.f;
    {
        const float* k0 = ck + (size_t)(lane + 1) * 128; const float* k1 = (lane < 63) ? ck + (size_t)(lane + 65) * 128 : k0;
        {
            f32x4 ka[16];
#pragma unroll
            for (int d = 0; d < 16; ++d) ka[d] = *(const f32x4*)(k0 + 4 * d);
#pragma unroll
            for (int d = 0; d < 16; ++d) { const f32x4 qv = *(const LAS f32x4*)(qs + 4 * d); s0 += ka[d].x * qv.x + ka[d].y * qv.y + ka[d].z * qv.z + ka[d].w * qv.w; }
        }
        asm volatile("" ::: "memory");
        {
            f32x4 kb[16];
#pragma unroll
            for (int d = 0; d < 16; ++d) kb[d] = *(const f32x4*)(k1 + 4 * d);
#pragma unroll
            for (int d = 0; d < 16; ++d) { const f32x4 qv = *(const LAS f32x4*)(qs + 4 * d); s1 += kb[d].x * qv.x + kb[d].y * qv.y + kb[d].z * qv.z + kb[d].w * qv.w; }
        }
        const float snew = wave_sum(qd * kd);
        if (lane == 63) s1 = snew;
    }
    s0 *= 0.125f; s1 *= 0.125f;
    const float sink = IN(9)[l * 8 + hq];
    const float mx = fmaxf(wave_max(fmaxf(s0, s1)), sink);
    const float p0 = __expf(s0 - mx), p1 = __expf(s1 - mx);
    const float sum = wave_sum(p0 + p1) + __expf(sink - mx);
    asm volatile("" ::: "memory");
    const int g4 = lane >> 4, d4 = (lane & 15) * 4;
    f32x4 o4 = (f32x4){0.f, 0.f, 0.f, 0.f};
#pragma unroll 1
    for (int i0 = 0; i0 < 32; i0 += 8) {
        f32x4 vv[8];
#pragma unroll
        for (int j = 0; j < 8; ++j) { const int x = 4 * (i0 + j) + g4; vv[j] = (f32x4){0.f, 0.f, 0.f, 0.f}; if (x < 127) vv[j] = *(const f32x4*)(cv + (size_t)(x + 1) * 128 + d4); }
#pragma unroll
        for (int j = 0; j < 8; ++j) { const int x = 4 * (i0 + j) + g4; const float p = __shfl(i0 < 16 ? p0 : p1, x & 63); o4 += vv[j] * p; }
    }
    { const float pn = __shfl(p1, 63); const float vn0 = __shfl(vd, d4), vn1 = __shfl(vd, d4 + 1), vn2 = __shfl(vd, d4 + 2), vn3 = __shfl(vd, d4 + 3);
      if (g4 == 0) o4 += (f32x4){vn0, vn1, vn2, vn3} * pn; }
#pragma unroll
    for (int e = 0; e < 4; ++e) { o4[e] += __shfl_xor(o4[e], 16); o4[e] += __shfl_xor(o4[e], 32); }
    if (lane < 16) { const float rs = 1.0f / sum; u32x2 wv; wv.x = pk2(o4.x * rs, o4.y * rs); wv.y = pk2(o4.z * rs, o4.w * rs);
        *(u32x2*)(WSP(bf16_t, WS_MIX) + (size_t)(MP + b) * DM + hq * 64 + d4) = wv; }
}
__device__ __forceinline__ void hgrn_sample_wave(const Ctx& C, int l, int wi) {
    const int b = wi >> 2, h = wi & 3, lane = C.lane;
    const bf16_t* rp = WSP(bf16_t, WS_PROJ) + (size_t)(MP + b) * DIN;
    const float lbv = hgrn_lb(C, l, h * 64 + lane);
    const float f = lbv + (1.0f - lbv) * sigmoid_f(bf2f(rp[1536 + h * 64 + lane])), kk = 1.0f - f;
    const float q = bf2f(rp[1280 + h * 64 + lane]), iv = bf2f(rp[1792 + h * 64 + lane]), cg = bf2f(rp[2048 + h * 64 + lane]);
    const float* S0 = IN(4) + (size_t)((l * 128 + b) * 4 + h) * 4096; float* So = C.out + O_HSS + (size_t)((l * 128 + b) * 4 + h) * 4096;
    float o = 0.f;
#pragma unroll 16
    for (int k = 0; k < 64; ++k) { const float fk = __shfl(f, k), kkk = __shfl(kk, k), qk = __shfl(q, k);
        const float S = fk * S0[k * 64 + lane] + kkk * iv; So[k * 64 + lane] = S; o += qk * S; }
    const float ms = wave_sum(o * o) * (1.0f / 64.0f);
    const float y = o * (1.0f / sqrtf(ms + 1e-6f)) * IN(15)[l * 64 + lane] * silu2(cg);
    WSP(bf16_t, WS_MIX)[(size_t)(MP + b) * DM + 768 + h * 64 + lane] = (bf16_t)f2bf(y);
}
__device__ __forceinline__ void gmlp_sample_wave(const Ctx& C, int l, int b) {
    const int lane = C.lane, c = 4 * lane, g = c >> 6;
    const bf16_t* rp = WSP(bf16_t, WS_PROJ) + (size_t)(MP + b) * DIN;
    const u32x2 gw = *(const u32x2*)(rp + 1024 + c), uw = *(const u32x2*)(rp + 768 + c);
    float x[4] = {bf2f(gw.x & 0xffffu), bf2f(gw.x >> 16), bf2f(gw.y & 0xffffu), bf2f(gw.y >> 16)};
    const float u[4] = {bf2f(uw.x & 0xffffu), bf2f(uw.x >> 16), bf2f(uw.y & 0xffffu), bf2f(uw.y >> 16)};
    const float mean = wave_sum(x[0] + x[1] + x[2] + x[3]) * (1.0f / 256.0f);
    float sq = 0.f;
#pragma unroll
    for (int i = 0; i < 4; ++i) { x[i] -= mean; sq += x[i] * x[i]; }
    const float rstd = 1.0f / sqrtf(wave_sum(sq) * (1.0f / 256.0f) + 1e-5f);
    const float w00 = IN(12)[(size_t)(l * 4 + g) * 128 * 128], b0 = IN(13)[(l * 4 + g) * 128];
    float vn[4], y[4];
#pragma unroll
    for (int i = 0; i < 4; ++i) { vn[i] = x[i] * rstd * IN(10)[l * 256 + c + i] + IN(11)[l * 256 + c + i]; y[i] = u[i] * (w00 * vn[i] + b0); }
    *(f32x4*)(C.out + O_GV + (size_t)(l * 128 + b) * 256 + c) = (f32x4){vn[0], vn[1], vn[2], vn[3]};
    u32x2 wv; wv.x = pk2(y[0], y[1]); wv.y = pk2(y[2], y[3]);
    *(u32x2*)(WSP(bf16_t, WS_MIX) + (size_t)(MP + b) * DM + 512 + c) = wv;
}

__device__ __forceinline__ void sample_gemm(const Ctx& C, const bf16_t* A, int K, const bf16_t* Bt) {
    int lane = C.lane; asm volatile("" : "+v"(lane));
    const int fr = lane & 15, fq = lane >> 4, kl = K >> 2;
    for (int it = C.bid; it < 256; it += C.G) {
        const int cgp = it & 63, ks = it >> 6;
        const bf16_t* ap = A + (size_t)(C.wave * 16 + fr) * K + ks * kl + fq * 8; const bf16_t* bp = Bt + (size_t)(cgp * 16 + fr) * K + ks * kl + fq * 8;
        f32x4 acc = (f32x4){0.f, 0.f, 0.f, 0.f};
        if (kl == 704) {
#pragma unroll 1
            for (int s0 = 0; s0 < 704; s0 += 352) { bf16x8 av[11], bv[11];
#pragma unroll
                for (int j = 0; j < 11; ++j) { av[j] = *(const bf16x8*)(ap + s0 + 32 * j); bv[j] = *(const bf16x8*)(bp + s0 + 32 * j); }
#pragma unroll
                for (int j = 0; j < 11; ++j) acc = __builtin_amdgcn_mfma_f32_16x16x32_bf16(av[j], bv[j], acc, 0, 0, 0); }
        } else {
#pragma unroll 8
            for (int s = 0; s < kl; s += 32) acc = __builtin_amdgcn_mfma_f32_16x16x32_bf16(*(const bf16x8*)(ap + s), *(const bf16x8*)(bp + s), acc, 0, 0, 0);
        }
        float* yo = WSP(float, WS_YS) + ((size_t)ks * 128 + C.wave * 16 + fq * 4) * DM + cgp * 16 + fr;
#pragma unroll
        for (int i = 0; i < 4; ++i) yo[(size_t)i * DM] = acc[i];
    }
}

#define FRESH_CTX(C2, C) Ctx C2 = (C); { int z2_; asm volatile("s_mov_b32 %0, 0" : "=s"(z2_)); C2.ws = (C).ws + z2_; C2.out = (C).out + z2_; C2.in = (C).in + z2_; }
#ifndef XMODE
#define XMODE 0
#endif
__device__ __forceinline__ void phase_mix1(const Ctx& C, int l, int rep = 0) {
    if (!rep) for (int it = C.bid; it < 256; it += C.G) { FRESH_CTX(C2, C); attn_prompt_item(C2, l, it); }
    for (int it = C.bid; it < 256; it += C.G) { FRESH_CTX(C2, C); hgrn_local_item(C2, l, it, rep ? XMODE : 0); }
}
__device__ __forceinline__ void phase_mix2(const Ctx& C, int l, int rep = 0) {
    if (rep == 0) hgrn_scan(C, l);
#ifndef T_AS
#define T_AS 1
#define T_GP 1
#define T_HS 1
#define T_GS 1
#endif
    if (T_AS) for (int it = C.bid; it < 128; it += C.G) attn_sample_item(C, l, it);
    if (T_GP) for (int it = C.bid; it < 512; it += C.G) { FRESH_CTX(C2, C); gmlp_prompt_item(C2, l, it); }
    if (T_HS) for (int it = (C.bid + 128) % C.G; it < 64; it += C.G) hgrn_sample_wave(C, l, it * 8 + C.wave);
    if (T_GS) for (int it = (C.bid + 64) % C.G; it < 16; it += C.G) gmlp_sample_wave(C, l, it * 8 + C.wave);
}
__device__ __forceinline__ void phase_mix3(const Ctx& C, int l) {
    for (int it = C.bid; it < 256; it += C.G) { FRESH_CTX(C2, C); hgrn_corr_item(C2, l, it); }
}

#define XB_TMO      128
#define XB_XCNT(j)  (256  + 64 * (j))
#define XB_XSUB(j)  (1280 + 64 * (j))
#define XB_XGEN(j)  (2304 + 64 * (j))
#define XB_TOP      3328
#define XB_TOPGEN   3392
#define XCD_BAR_WORDS 3456
#define XB_SPIN_CAP (1u << 18)

__device__ __forceinline__ unsigned xb_ld(unsigned* p)              { return __hip_atomic_load(p, __ATOMIC_RELAXED, __HIP_MEMORY_SCOPE_AGENT); }
__device__ __forceinline__ unsigned xb_add(unsigned* p, unsigned v) { return __hip_atomic_fetch_add(p, v, __ATOMIC_RELAXED, __HIP_MEMORY_SCOPE_AGENT); }
__device__ __forceinline__ unsigned xb_xcc_id() { return (unsigned)__builtin_amdgcn_s_getreg((3 << 11) | 20) & 0xFu; }
#define XB_SPIN(cond, bar) do { unsigned _sp = 0; while (cond) { __builtin_amdgcn_s_sleep(1); \
    if ((++_sp & 255u) == 0u) { if (xb_ld(&(bar)[XB_TMO])) break; if (_sp > XB_SPIN_CAP) { atomicAdd(&(bar)[XB_TMO], 1u); break; } } } } while (0)

struct XcdBarrier {
    unsigned* bar; unsigned x;
    volatile LAS unsigned* st;
};

__device__ __forceinline__ XcdBarrier xcd_barrier_post(unsigned* bar, volatile LAS unsigned* st) {
    XcdBarrier b; b.bar = bar; b.x = xb_xcc_id(); b.st = st;
    if (threadIdx.x == 0) (void)xb_add(&bar[XB_XCNT(b.x)], 1u);
    return b;
}
__device__ __forceinline__ void xcd_barrier_complete(unsigned* bar, unsigned x, unsigned& nloc, unsigned& nx) {
    const unsigned G = gridDim.x * gridDim.y * gridDim.z;
    unsigned sum, cnt, mine, sp = 0u;
    for (;;) {
        sum = 0u; cnt = 0u; mine = 0u;
#pragma unroll
        for (unsigned j = 0; j < 16; ++j) { const unsigned c = xb_ld(&bar[XB_XCNT(j)]); sum += c; cnt += (c > 0u) ? 1u : 0u; mine = (j == x) ? c : mine; }
        if (sum == G) break;
        __builtin_amdgcn_s_sleep(1);
        if ((++sp & 255u) == 0u) { if (xb_ld(&bar[XB_TMO])) break; if (sp > XB_SPIN_CAP) { atomicAdd(&bar[XB_TMO], 1u); break; } }
    }
    nloc = mine > 0u ? mine : 1u; nx = cnt > 0u ? cnt : 1u;
}

__device__ __forceinline__ void xcd_barrier(const XcdBarrier& b) {
    asm volatile("s_waitcnt vmcnt(0)" ::: "memory");
    __syncthreads();
    if (threadIdx.x == 0) {
        unsigned* bar = b.bar;
        __builtin_amdgcn_s_waitcnt(0);
        unsigned nloc = b.st[0], nx = b.st[1];
        if (nloc == 0u) { xcd_barrier_complete(bar, b.x, nloc, nx); b.st[0] = nloc; b.st[1] = nx; }
        const unsigned old = xb_add(&bar[XB_XSUB(b.x)], 1u);
        const unsigned gen = old / nloc;
        if (old + 1u == (gen + 1u) * nloc) {
            __builtin_amdgcn_fence(__ATOMIC_RELEASE, "agent");
            asm volatile("s_waitcnt vmcnt(0)" ::: "memory");
            const unsigned og = xb_add(&bar[XB_TOP], 1u);
            const unsigned tg = og / nx;
            if (og + 1u == (tg + 1u) * nx) xb_add(&bar[XB_TOPGEN], 1u);
            else XB_SPIN(xb_ld(&bar[XB_TOPGEN]) == tg, bar);
            __builtin_amdgcn_fence(__ATOMIC_ACQUIRE, "agent");
            xb_add(&bar[XB_XGEN(b.x)], 1u);
            asm volatile("s_waitcnt vmcnt(0)" ::: "memory");
        } else {
            XB_SPIN(xb_ld(&bar[XB_XGEN(b.x)]) == gen, bar);
            __builtin_amdgcn_fence(__ATOMIC_ACQUIRE, "agent");
            asm volatile("s_waitcnt vmcnt(0)" ::: "memory");
        }
    }
    __syncthreads();
}

#ifndef T_PRO
#define T_PRO 1
#endif
#ifndef T_G1
#define T_G1 1
#endif
#ifndef T_G2
#define T_G2 1
#endif
#ifndef T_G3
#define T_G3 1
#endif
#ifndef T_M1
#define T_M1 1
#endif
#ifndef T_M2
#define T_M2 1
#endif
#ifndef T_M3
#define T_M3 1
#endif
__global__ void __launch_bounds__(512, 2) mega_fwd(Args args) {
    extern __shared__ __attribute__((aligned(16))) unsigned char lds[];
    Ctx C;
    C.lds = (LAS unsigned char*)lds; C.tid = threadIdx.x; C.lane = C.tid & 63; C.wave = __builtin_amdgcn_readfirstlane(C.tid >> 6);
    C.G = gridDim.x; C.bid = blockIdx.x; C.in = args.in; C.out = args.out; C.ws = args.ws;
    cg::grid_group grid = cg::this_grid();
    volatile LAS unsigned* bst = (volatile LAS unsigned*)(C.lds + LDS_BYTES - 64);
    if (C.tid < 2) bst[C.tid] = 0u;
    __syncthreads();
    const XcdBarrier xbar = xcd_barrier_post((unsigned*)(args.ws + 16384), bst);
    const Ctx C0 = C;
#ifndef XDUP
#define XDUP (-1)
#endif
#ifndef XDUPN
#define XDUPN 1
#endif
    for (int pi_ = args.ph_lo; pi_ < args.ph_hi + (XDUP >= 0 ? XDUPN : 0); ++pi_) {
        int ph = pi_, XR_ = 0;
        if (XDUP >= 0 && pi_ >= XDUP) { const int o_ = pi_ - XDUP; if (o_ < 2 * XDUPN) { ph = XDUP + (o_ >> 1); XR_ = o_ & 1; } else ph = pi_ - XDUPN; }
        {
            int z_; int t_ = C0.tid;
            asm volatile("s_mov_b32 %0, 0" : "=s"(z_)); asm volatile("" : "+v"(t_));
            C.ws = C0.ws + z_; C.out = C0.out + z_; C.in = C0.in + z_; C.tid = t_; C.lane = t_ & 63;
        }
        if (ph == 0) { if (T_PRO) phase_prologue(C, XR_); }
        else if (ph == 1) phase_mod0(C);
        else {
            const int l = (ph - 2) / 12, s = (ph - 2) % 12;
            if (T_G1 && (s == 0 || s == 9 || s == 1 || s == 10 || s == 7 || s == 3)) {
                const int f2 = (s >= 9) ? 1 : 0, mi = l * 2 + f2;
                pg8::Gemm g; pg8::EpiMulti E; E.O = nullptr; E.ldc = 0; E.X = nullptr; E.Xw = nullptr; E.gate = nullptr; E.scale = 0.f; E.Xf = nullptr; E.ST = nullptr; E.pg = nullptr; E.pb = nullptr;
                { const int li = l * 3 + (s == 1 ? 0 : s == 7 ? 1 : 2);
                  if (s == 1 || s == 7 || s == 10) { if (li == 0) E.Xf = IN(0); else { E.ST = WSP(float, WS_ST); E.pg = IN(22) + (size_t)(li - 1) * DM; E.pb = IN(23) + (size_t)(li - 1) * DM; } } }
                if (s == 0 || s == 9) {
                    g = pg8::Gemm{WSP(pg8::bf16_t, WS_H), WSP(pg8::bf16_t, WS_FFIN) + (size_t)mi * 2 * DFF * DM, MPAD, 2 * DFF, DM};
                    E.mode = 0; E.O = WSP(pg8::bf16_t, WS_ACT); E.ldc = DFF;
                } else if (s == 1 || s == 10) {
                    g = pg8::Gemm{WSP(pg8::bf16_t, WS_ACT), WSP(pg8::bf16_t, WS_FFOUT) + (size_t)mi * DM * DFF, MP, DM, DFF};
                    E.mode = 2; E.X = WSP(pg8::bf16_t, WS_XB); E.gate = WSP(float, WS_MOD) + (size_t)l * NCROW * MODW + (size_t)(s == 1 ? 2 : 8) * DM; E.scale = 0.5f;
                } else if (s == 7) {
                    g = pg8::Gemm{WSP(pg8::bf16_t, WS_MIX), WSP(pg8::bf16_t, WS_WOUT) + (size_t)l * DM * DM, MP, DM, DM};
                    E.mode = 2; E.X = WSP(pg8::bf16_t, WS_XB); E.gate = WSP(float, WS_MOD) + (size_t)l * NCROW * MODW + (size_t)5 * DM; E.scale = 1.0f;
                } else {
                    g = pg8::Gemm{WSP(pg8::bf16_t, WS_H), WSP(pg8::bf16_t, WS_WIN) + (size_t)l * DIN * DM, MPAD, DIN, DM};
                    E.mode = 1; E.O = WSP(pg8::bf16_t, WS_PROJ); E.ldc = DIN;
                }
                E.Xw = XR_ ? (pg8::bf16_t*)(C.ws + 273 * MiB) : E.X;
                pg8::StaticOrder S; S.init(g.M, g.N, C.G, C.bid);
                pg8::gemm_phase<pg8::EpiMulti, pg8::StaticOrder, true, true>(C.lds, g, S, E);
                if (E.mode == 2) sample_gemm(C, g.A + (size_t)MP * g.K, g.K, g.Bt);
            } else if (s == 2) phase_ln(C, l, 0, XR_);
            else if (s == 8) phase_ln(C, l, 1, XR_);
            else if (s == 11) phase_ln(C, l, 2, (l == 1) ? 0 : XR_);
            else if (s == 4) { if (T_M1) phase_mix1(C, l, XR_); }
            else if (s == 5) { if (T_M2) phase_mix2(C, l, XR_); }
            else { if (T_M3) phase_mix3(C, l); }
        }
        if (pi_ + 1 < args.ph_hi + (XDUP >= 0 ? XDUPN : 0)) { if (args.ph_lo < 0) grid.sync(); else xcd_barrier(xbar); }
    }
}

#ifndef MK_ONE_LAUNCH
#define MK_ONE_LAUNCH 1
#endif
extern "C" void kernel_launch(void* const* d_in, const int* in_sizes, int n_in, void* d_out, int out_size, void* d_ws, size_t ws_size, hipStream_t stream) {
    static int grid = 0;
    if (grid == 0) {
        if (n_in != 24 || ws_size < WS_END) { fprintf(stderr, "kernel_launch: unexpected n_in %d / ws %zu\n", n_in, ws_size); grid = -1; return; }
        int dev = 0, cus = 0, per_cu = 0;
        (void)hipGetDevice(&dev); (void)hipDeviceGetAttribute(&cus, hipDeviceAttributeMultiprocessorCount, dev);
        if (hipFuncSetAttribute((const void*)mega_fwd, hipFuncAttributeMaxDynamicSharedMemorySize, LDS_BYTES) != hipSuccess) { fprintf(stderr, "kernel_launch: hipFuncSetAttribute failed\n"); grid = -1; return; }
        if (hipOccupancyMaxActiveBlocksPerMultiprocessor(&per_cu, (const void*)mega_fwd, 512, LDS_BYTES) != hipSuccess || per_cu < 1) { fprintf(stderr, "kernel_launch: occupancy query gave %d\n", per_cu); per_cu = 1; }
        (void)hipGetLastError();
        grid = cus > 0 ? cus : 256;
    }
    if (grid < 0) return;
    (void)hipMemsetAsync(d_ws, 0, 65536, stream);
    Args a{};
    for (int i = 0; i < 24; ++i) a.in[i] = (const float*)d_in[i];
    a.out = (float*)d_out; a.ws = (unsigned char*)d_ws;
#if MK_ONE_LAUNCH
    a.ph_lo = 0; a.ph_hi = NPH;
    void* kargs[] = {&a};
    hipError_t e = hipLaunchCooperativeKernel((const void*)mega_fwd, dim3(grid), dim3(512), kargs, LDS_BYTES, stream);
    if (e != hipSuccess) fprintf(stderr, "kernel_launch: cooperative launch failed: %s (grid %d)\n", hipGetErrorString(e), grid);
#else
    for (int ph = 0; ph < NPH; ++ph) { a.ph_lo = ph; a.ph_hi = ph + 1; hipLaunchKernelGGL(mega_fwd, dim3(grid), dim3(512), LDS_BYTES, stream, a); }
#endif
}
```

```cpp
#include <hip/hip_runtime.h>
#include <hip/hip_cooperative_groups.h>
#include <cstdio>
#include <cstdint>
namespace cg = cooperative_groups;

constexpr int DM = 1024, SEQ = 8192, MP = 16384, DECB = 128, MR = MP + DECB, MPAD = 16640;
constexpr int DIN = 2304, DFF = 2816, MODW = 9216, NCROW = 130, DEPTH = 2;
constexpr float ALPHA_F = 1.41421356237f;
__device__ __forceinline__ int crow_of(int r) { return r < MP ? (r >> 13) : (r < MR ? 2 + (r - MP) : 129); }

namespace pg8 {
#define PG8_LAS __attribute__((address_space(3)))
typedef unsigned short bf16_t;
typedef short bf16x8 __attribute__((ext_vector_type(8)));
typedef float f32x4 __attribute__((ext_vector_type(4)));
typedef unsigned u32x4 __attribute__((ext_vector_type(4)));
constexpr int BM = 256, BK = 64, HALF = 128, HTB = HALF * BK * 2  , STAGE_BYTES = 8 * HTB, NXCD = 8, WGM = 8;

__host__ __device__ __forceinline__ int lds_byte(int r, int c) { const int st = (r >> 4) * 2 + (c >> 5), rr = r & 15, cc = c & 31, ob = rr * 64 + cc * 2; return st * 1024 + (ob ^ (((ob >> 9) & 1) << 5)); }
__host__ __device__ __forceinline__ void stage_rc(int b, int& R, int& C) { const int st = b / 1024, sb = b % 1024, swz = sb ^ (((sb >> 9) & 1) << 5); R = (st >> 1) * 16 + swz / 64; C = (st & 1) * 32 + (swz % 64) / 2; }
__host__ __device__ __forceinline__ int perm32(int rho) { const int n = rho >> 4, i = rho & 15; return 8 * (i >> 2) + 4 * n + (i & 3); }

struct Unit { int pm, pn; };
struct Gemm { const bf16_t* A; const bf16_t* Bt; int M, N, K; };

struct StaticOrder {
    int nM, nN, nwg, G, c;
    __host__ __device__ void init(int M, int N, int G_, int c_) { nM = M / BM; nN = N / BM; nwg = nM * nN; G = G_; c = c_; }
    __host__ __device__ bool next(int i, Unit& u) const {
        const long L = (long)i * G + c; if (L >= nwg) return false;
        int wgid = (int)L; { const int q = nwg / NXCD, r = nwg % NXCD, xcd = wgid % NXCD, off = wgid / NXCD; wgid = (xcd < r ? xcd * (q + 1) : r * (q + 1) + (xcd - r) * q) + off; }
        const int nig = WGM * nN, gid = wgid / nig, fm = gid * WGM, gsz = (nM - fm) < WGM ? (nM - fm) : WGM;
        u.pm = fm + ((wgid % nig) % gsz); u.pn = (wgid % nig) / gsz; return true;
    }
    __device__ __forceinline__ void a_ready(const Unit&) const {}
    __device__ __forceinline__ void done(const Unit&) const {}
};

__device__ __forceinline__ unsigned cvt_pk_bf16(float lo, float hi) { unsigned r; asm volatile("v_cvt_pk_bf16_f32 %0, %1, %2" : "=v"(r) : "v"(lo), "v"(hi)); return r; }
typedef float f32x2 __attribute__((ext_vector_type(2)));

__device__ __forceinline__ float silu_f(float g) { return g * __builtin_amdgcn_rcpf(1.0f + __expf(-g)); }
struct EpiSwiglu {
    static constexpr bool PERM = true, AFTER_DRAIN = false;
    bf16_t* O;
    __device__ __forceinline__ void operator()(const f32x4 (&acc)[2][2][4][2], const Unit& u, int wr, int wc, int fr, int fq) const {
        const int row0 = u.pm * BM + wr * 64 + fr, col0 = u.pn * HALF + wc * 32 + 8 * fq;
#pragma unroll
        for (int ai = 0; ai < 2; ++ai)
#pragma unroll
            for (int m = 0; m < 4; ++m) {
                bf16_t* rowp = O + (size_t)(row0 + ai * HALF + m * 16) * DFF + col0;
                const f32x4 a0 = acc[ai][0][m][0], a1 = acc[ai][0][m][1], g0 = acc[ai][1][m][0], g1 = acc[ai][1][m][1];
                u32x4 w;
                w.x = cvt_pk_bf16(silu_f(g0[0]) * a0[0], silu_f(g0[1]) * a0[1]); w.y = cvt_pk_bf16(silu_f(g0[2]) * a0[2], silu_f(g0[3]) * a0[3]);
                w.z = cvt_pk_bf16(silu_f(g1[0]) * a1[0], silu_f(g1[1]) * a1[1]); w.w = cvt_pk_bf16(silu_f(g1[2]) * a1[2], silu_f(g1[3]) * a1[3]);
                *(u32x4*)rowp = w;
            }
    }
};
struct EpiStore {
    static constexpr bool PERM = true, AFTER_DRAIN = false;
    bf16_t* O; int ldc;
    __device__ __forceinline__ void operator()(const f32x4 (&acc)[2][2][4][2], const Unit& u, int wr, int wc, int fr, int fq) const {
        const int row0 = u.pm * BM + wr * 64 + fr, col0 = u.pn * BM + wc * 32 + 8 * fq;
#pragma unroll
        for (int ai = 0; ai < 2; ++ai)
#pragma unroll
            for (int m = 0; m < 4; ++m) {
                bf16_t* rowp = O + (size_t)(row0 + ai * HALF + m * 16) * ldc + col0;
#pragma unroll
                for (int bj = 0; bj < 2; ++bj) {
                    const f32x4 v0 = acc[ai][bj][m][0], v1 = acc[ai][bj][m][1];
                    u32x4 w; w.x = cvt_pk_bf16(v0[0], v0[1]); w.y = cvt_pk_bf16(v0[2], v0[3]); w.z = cvt_pk_bf16(v1[0], v1[1]); w.w = cvt_pk_bf16(v1[2], v1[3]);
                    *(u32x4*)(rowp + bj * HALF) = w;
                }
            }
    }
};
struct EpiResid {
    static constexpr bool PERM = false, AFTER_DRAIN = false;
    float* X; const float* gate; float scale;
    __device__ __forceinline__ void operator()(const f32x4 (&acc)[2][2][4][2], const Unit& u, int wr, int wc, int fr, int fq) const {
#pragma unroll
        for (int ai = 0; ai < 2; ++ai)
#pragma unroll
            for (int m = 0; m < 4; ++m) {
                const int r = u.pm * BM + ai * HALF + wr * 64 + m * 16 + fr;
                if (r < MR) {
                    const float* gp = gate + (size_t)crow_of(r) * MODW; float* xp = X + (size_t)r * DM;
#pragma unroll
                    for (int bj = 0; bj < 2; ++bj)
#pragma unroll
                        for (int n = 0; n < 2; ++n) {
                            const int c = u.pn * BM + bj * HALF + wc * 32 + n * 16 + 4 * fq;
                            const f32x4 gv = *(const f32x4*)(gp + c); const f32x4 xv = *(const f32x4*)(xp + c);
                            *(f32x4*)(xp + c) = xv * ALPHA_F + (gv + 1.0f) * (acc[ai][bj][m][n] * scale);
                        }
                }
            }
    }
};

struct EpiMulti {
    static constexpr bool PERM = true, AFTER_DRAIN = false;
    int mode; bf16_t* O; int ldc; bf16_t* X; bf16_t* Xw; const float* gate; float scale;
    const float* Xf; const float* ST; const float* pg; const float* pb;
    __device__ __forceinline__ void operator()(const f32x4 (&acc)[2][2][4][2], const Unit& u, int wr, int wc, int fr, int fq) const {
        if (mode == 0) { EpiSwiglu e{O}; e(acc, u, wr, wc, fr, fq); }
        else { EpiStore e{O, ldc}; e(acc, u, wr, wc, fr, fq); }
    }
    __device__ __forceinline__ bool after_drain() const { return mode == 2; }
    __device__ __forceinline__ void fused(const f32x4 (&acc)[2][2][4][2], const Unit& u, int wr, int wc, int fr, int fq, PG8_LAS unsigned char*, int, int) const {
        {
            const int r0 = u.pm * BM + wr * 64 + fr, cb = u.pn * BM + wc * 32 + 8 * fq;
            const float* gp = gate + (size_t)crow_of(u.pm * BM) * MODW + cb;
            f32x4 G[2][2];
#pragma unroll
            for (int bj = 0; bj < 2; ++bj) { G[bj][0] = *(const f32x4*)(gp + bj * HALF) + 1.0f; G[bj][1] = *(const f32x4*)(gp + bj * HALF + 4) + 1.0f; }
            if (Xf != nullptr) {
#pragma unroll
                for (int ai = 0; ai < 2; ++ai)
#pragma unroll
                    for (int m = 0; m < 4; ++m) { const int r = r0 + ai * HALF + m * 16;
#pragma unroll
                        for (int bj = 0; bj < 2; ++bj) { const float* sp = Xf + (size_t)r * DM + cb + bj * HALF;
                            const f32x4 z0 = *(const f32x4*)sp * ALPHA_F + G[bj][0] * (acc[ai][bj][m][0] * scale), z1 = *(const f32x4*)(sp + 4) * ALPHA_F + G[bj][1] * (acc[ai][bj][m][1] * scale);
                            u32x4 o; o.x = cvt_pk_bf16(z0[0], z0[1]); o.y = cvt_pk_bf16(z0[2], z0[3]); o.z = cvt_pk_bf16(z1[0], z1[1]); o.w = cvt_pk_bf16(z1[2], z1[3]);
                            *(u32x4*)(Xw + (size_t)r * DM + cb + bj * HALF) = o; } }
            } else {
#pragma unroll
                for (int bj = 0; bj < 2; ++bj) {
                    const int cc = cb + bj * HALF;
                    const f32x4 PG0 = *(const f32x4*)(pg + cc), PG1 = *(const f32x4*)(pg + cc + 4), PB0 = *(const f32x4*)(pb + cc), PB1 = *(const f32x4*)(pb + cc + 4);
                    u32x4 nx = *(const u32x4*)(X + (size_t)r0 * DM + cc); float nmean = ST[2 * r0], nrstd = ST[2 * r0 + 1];
#pragma unroll
                    for (int idx = 0; idx < 8; ++idx) {
                        const int ai = idx >> 2, m = idx & 3, r = r0 + ai * HALF + m * 16;
                        const u32x4 w = nx; const float mean = nmean, rstd = nrstd;
                        if (idx < 7) { const int rn = r0 + ((idx + 1) >> 2) * HALF + ((idx + 1) & 3) * 16; nx = *(const u32x4*)(X + (size_t)rn * DM + cc); nmean = ST[2 * rn]; nrstd = ST[2 * rn + 1]; }
                        f32x4 x0 = (f32x4){__uint_as_float(w.x << 16), __uint_as_float(w.x & 0xffff0000u), __uint_as_float(w.y << 16), __uint_as_float(w.y & 0xffff0000u)};
                        f32x4 x1 = (f32x4){__uint_as_float(w.z << 16), __uint_as_float(w.z & 0xffff0000u), __uint_as_float(w.w << 16), __uint_as_float(w.w & 0xffff0000u)};
                        x0 = (x0 - mean) * rstd * PG0 + PB0; x1 = (x1 - mean) * rstd * PG1 + PB1;
                        const f32x4 z0 = x0 * ALPHA_F + G[bj][0] * (acc[ai][bj][m][0] * scale), z1 = x1 * ALPHA_F + G[bj][1] * (acc[ai][bj][m][1] * scale);
                        u32x4 o; o.x = cvt_pk_bf16(z0[0], z0[1]); o.y = cvt_pk_bf16(z0[2], z0[3]); o.z = cvt_pk_bf16(z1[0], z1[1]); o.w = cvt_pk_bf16(z1[2], z1[3]);
                        *(u32x4*)(Xw + (size_t)r * DM + cc) = o;
                        asm volatile("" ::: "memory");
                    }
                }
            }
        }
    }
};
template <class Epi, class Sched, bool ALIGN_EPI = false, bool SP2 = false>
__device__ __forceinline__ void gemm_phase(PG8_LAS unsigned char* lds, const Gemm g, const Sched& S, const Epi& E) {
    const int tid = threadIdx.x, wid = __builtin_amdgcn_readfirstlane(tid >> 6), lane = tid & 63, wr = wid >> 2, wc = wid & 3, fr = lane & 15, fq = lane >> 4;
    const int K = g.K, nt = K / BK;
    unsigned voffA[2], voffB[2];
#pragma unroll
    for (int i = 0; i < 2; ++i) { int R, C; stage_rc(tid * 16 + i * 8192, R, C); const int Rb = Epi::PERM ? ((R & ~31) + perm32(R & 31)) : R;
        voffA[i] = (unsigned)(R * K + C) * 2u; voffB[i] = (unsigned)(Rb * K + C) * 2u; }
    const size_t kstep = (size_t)(BK * 2);
    const size_t hstep = (size_t)HALF * K * 2;
    const size_t tstep = 2 * hstep;
    const unsigned ldsw = (unsigned)wid * 1024u;
    const int aoff = lds_byte(wr * 64 + fr, fq * 8), boff = lds_byte(wc * 32 + fr, fq * 8);
#define PG8_SA(b, h) (((b) * 2 + (h)) * HTB)
#define PG8_SB(b, h) ((4 + (b) * 2 + (h)) * HTB)
#define PG8_STAGE(bufoff, gbase, voff) do { _Pragma("unroll") for (int _i = 0; _i < 2; ++_i) \
        __builtin_amdgcn_global_load_lds((const unsigned*)((const char*)(gbase) + (voff)[_i]), (PG8_LAS unsigned*)(lds + (bufoff) + ldsw + _i * 8192), 16, 0, 0); } while (0)
#define PG8_LDA(dst, b, h) do { _Pragma("unroll") for (int m = 0; m < 4; ++m) _Pragma("unroll") for (int k = 0; k < 2; ++k) dst[m][k] = *(const PG8_LAS bf16x8*)(lds + PG8_SA(b, h) + aoff + m * 2048 + k * 1024); } while (0)
#define PG8_LDB(dst, b, h) do { _Pragma("unroll") for (int n = 0; n < 2; ++n) _Pragma("unroll") for (int k = 0; k < 2; ++k) dst[n][k] = *(const PG8_LAS bf16x8*)(lds + PG8_SB(b, h) + boff + n * 2048 + k * 1024); } while (0)
#define PG8_MMA(ai, bj, At, Bt) do { __builtin_amdgcn_s_setprio(1); _Pragma("unroll") for (int m = 0; m < 4; ++m) _Pragma("unroll") for (int n = 0; n < 2; ++n) _Pragma("unroll") for (int k = 0; k < 2; ++k) \
        acc[ai][bj][m][n] = __builtin_amdgcn_mfma_f32_16x16x32_bf16(Bt[n][k], At[m][k], acc[ai][bj][m][n], 0, 0, 0); __builtin_amdgcn_s_setprio(0); } while (0)
#define PG8_WAIT_V(n) asm volatile("s_waitcnt vmcnt(" #n ")" ::: "memory")
#define PG8_WAIT_L(n) asm volatile("s_waitcnt lgkmcnt(" #n ")" ::: "memory")
#define PG8_BAR __builtin_amdgcn_s_barrier()
#define PG8_SCHED __builtin_amdgcn_sched_barrier(0)
    Unit cur, nxt; int ui = 0;
    if (!S.next(0, cur)) return;
    f32x4 acc[2][2][4][2];
#pragma unroll
    for (int a = 0; a < 2; ++a)
#pragma unroll
        for (int b = 0; b < 2; ++b)
#pragma unroll
            for (int m = 0; m < 4; ++m)
#pragma unroll
                for (int n = 0; n < 2; ++n) acc[a][b][m][n] = (f32x4){0.f, 0.f, 0.f, 0.f};
    bf16x8 At[4][2], B0[2][2], B1[2][2];
    const char* cA = (const char*)g.A + (size_t)cur.pm * tstep; const char* cB = (const char*)g.Bt + (size_t)cur.pn * tstep;
    S.a_ready(cur);
    if constexpr (SP2) {
        PG8_STAGE(PG8_SB(0, 0), cB, voffB); PG8_STAGE(PG8_SB(0, 1), cB + hstep, voffB); PG8_STAGE(PG8_SA(0, 0), cA, voffA); PG8_STAGE(PG8_SA(0, 1), cA + hstep, voffA);
        if (wr == 1) PG8_BAR;
        PG8_WAIT_V(2); PG8_BAR;
        PG8_STAGE(PG8_SB(1, 0), cB + kstep, voffB); PG8_STAGE(PG8_SA(1, 0), cA + kstep, voffA); PG8_STAGE(PG8_SB(1, 1), cB + hstep + kstep, voffB);
        PG8_WAIT_V(6); PG8_BAR;
    } else {
        PG8_STAGE(PG8_SB(0, 0), cB, voffB); PG8_STAGE(PG8_SA(0, 0), cA, voffA); PG8_STAGE(PG8_SB(0, 1), cB + hstep, voffB); PG8_STAGE(PG8_SA(0, 1), cA + hstep, voffA);
        if (wr == 1) PG8_BAR;
        PG8_WAIT_V(4); PG8_BAR;
        PG8_STAGE(PG8_SB(1, 0), cB + kstep, voffB); PG8_STAGE(PG8_SA(1, 0), cA + kstep, voffA); PG8_STAGE(PG8_SB(1, 1), cB + hstep + kstep, voffB);
        PG8_WAIT_V(6); PG8_BAR;
    }
    for (;;) {
        const bool has_next = S.next(ui + 1, nxt);
        const char* nA = has_next ? (const char*)g.A + (size_t)nxt.pm * tstep : cA; const char* nB = has_next ? (const char*)g.Bt + (size_t)nxt.pn * tstep : cB;
        for (int t = 0; t < nt; t += 2) {
            const bool last = (t == nt - 2);
            const char* a1 = cA + (size_t)(t + 1) * kstep;
            const char* a2 = last ? nA : cA + (size_t)(t + 2) * kstep; const char* b2 = last ? nB : cB + (size_t)(t + 2) * kstep;
            const char* a3 = a2 + kstep; const char* b3 = b2 + kstep;
            if (last && has_next) S.a_ready(nxt);
            if constexpr (SP2) {
            PG8_LDB(B0, 0, 0); PG8_LDB(B1, 0, 1); PG8_SCHED; PG8_LDA(At, 0, 0); PG8_STAGE(PG8_SA(1, 1), a1 + hstep, voffA);
            PG8_WAIT_V(8); PG8_WAIT_L(0); PG8_BAR; PG8_MMA(0, 0, At, B0); PG8_MMA(0, 1, At, B1); PG8_BAR; PG8_SCHED;
            PG8_LDA(At, 0, 1); PG8_STAGE(PG8_SB(0, 0), b2, voffB); PG8_STAGE(PG8_SB(0, 1), b2 + hstep, voffB); PG8_STAGE(PG8_SA(0, 0), a2, voffA);
            PG8_WAIT_V(8); PG8_WAIT_L(0); PG8_BAR; PG8_MMA(1, 0, At, B0); PG8_MMA(1, 1, At, B1); PG8_BAR; PG8_SCHED;
            PG8_LDB(B0, 1, 0); PG8_LDB(B1, 1, 1); PG8_SCHED; PG8_LDA(At, 1, 0); PG8_STAGE(PG8_SA(0, 1), a2 + hstep, voffA);
            PG8_WAIT_V(8); PG8_WAIT_L(0); PG8_BAR; PG8_MMA(0, 0, At, B0); PG8_MMA(0, 1, At, B1); PG8_BAR; PG8_SCHED;
            PG8_LDA(At, 1, 1); PG8_STAGE(PG8_SB(1, 0), b3, voffB); PG8_STAGE(PG8_SB(1, 1), b3 + hstep, voffB); PG8_STAGE(PG8_SA(1, 0), a3, voffA);
            PG8_WAIT_V(8); PG8_WAIT_L(0); PG8_BAR; PG8_MMA(1, 0, At, B0); PG8_MMA(1, 1, At, B1); PG8_BAR; PG8_SCHED;
            } else {
            PG8_LDB(B0, 0, 0); PG8_SCHED; PG8_LDA(At, 0, 0); PG8_STAGE(PG8_SA(1, 1), a1 + hstep, voffA);
            PG8_WAIT_L(8); PG8_BAR; PG8_WAIT_L(0); PG8_MMA(0, 0, At, B0); PG8_BAR; PG8_SCHED;
            PG8_LDB(B1, 0, 1); PG8_STAGE(PG8_SB(0, 0), b2, voffB);
            PG8_BAR; PG8_WAIT_L(0); PG8_MMA(0, 1, At, B1); PG8_BAR;
            PG8_LDA(At, 0, 1); PG8_STAGE(PG8_SA(0, 0), a2, voffA);
            PG8_BAR; PG8_WAIT_L(0); PG8_MMA(1, 0, At, B0); PG8_BAR; PG8_SCHED;
            PG8_STAGE(PG8_SB(0, 1), b2 + hstep, voffB);
            PG8_WAIT_V(6); PG8_BAR; PG8_MMA(1, 1, At, B1); PG8_BAR;
            PG8_LDB(B0, 1, 0); PG8_SCHED; PG8_LDA(At, 1, 0); PG8_STAGE(PG8_SA(0, 1), a2 + hstep, voffA);
            PG8_WAIT_L(8); PG8_BAR; PG8_WAIT_L(0); PG8_MMA(0, 0, At, B0); PG8_BAR; PG8_SCHED;
            PG8_LDB(B1, 1, 1); PG8_STAGE(PG8_SB(1, 0), b3, voffB);
            PG8_BAR; PG8_WAIT_L(0); PG8_MMA(0, 1, At, B1); PG8_BAR;
            PG8_LDA(At, 1, 1); PG8_STAGE(PG8_SA(1, 0), a3, voffA);
            PG8_BAR; PG8_WAIT_L(0); PG8_MMA(1, 0, At, B0); PG8_BAR; PG8_SCHED;
            PG8_STAGE(PG8_SB(1, 1), b3 + hstep, voffB);
            PG8_WAIT_V(6); PG8_BAR; PG8_MMA(1, 1, At, B1); PG8_BAR;
            }
        }
        if constexpr (ALIGN_EPI) { if (wr == 0) PG8_BAR; }
        if (!E.after_drain()) { E(acc, cur, wr, wc, fr, fq); S.done(cur); }
        if (!has_next) break;
#pragma unroll
        for (int a = 0; a < 2; ++a)
#pragma unroll
            for (int b = 0; b < 2; ++b)
#pragma unroll
                for (int m = 0; m < 4; ++m)
#pragma unroll
                    for (int n = 0; n < 2; ++n) acc[a][b][m][n] = (f32x4){0.f, 0.f, 0.f, 0.f};
        cur = nxt; cA = nA; cB = nB; ++ui;
        if constexpr (ALIGN_EPI) { if (wr == 1) PG8_BAR; }
    }
    PG8_WAIT_V(0);
    if constexpr (!ALIGN_EPI) { if (wr == 0) PG8_BAR; }
    PG8_BAR;
    if (E.after_drain()) { E.fused(acc, cur, wr, wc, fr, fq, lds, wid, lane); S.done(cur); }
#undef PG8_SA
#undef PG8_SB
#undef PG8_STAGE
#undef PG8_LDA
#undef PG8_LDB
#undef PG8_MMA
#undef PG8_WAIT_V
#undef PG8_WAIT_L
#undef PG8_BAR
#undef PG8_SCHED
}
}

constexpr size_t MiB = 1u << 20;
constexpr size_t WS_FFIN = 1 * MiB;
constexpr size_t WS_FFOUT = 45 * MiB;
constexpr size_t WS_WIN = 67 * MiB;
constexpr size_t WS_WOUT = 76 * MiB;
constexpr size_t WS_MOD = 80 * MiB;
constexpr size_t WS_ROPE = 90 * MiB;
constexpr size_t WS_H = 91 * MiB;
constexpr size_t WS_ACT = 124 * MiB;
constexpr size_t WS_PROJ = 124 * MiB;
constexpr size_t WS_MIX = 198 * MiB;
constexpr size_t WS_HGS = 297 * MiB;
constexpr size_t WS_HGD = 235 * MiB;
constexpr size_t WS_YS = 236 * MiB;
constexpr size_t WS_ST = 238 * MiB;
constexpr size_t WS_XB = 240 * MiB;
constexpr size_t WS_OL = 273 * MiB;
constexpr size_t WS_QT = 289 * MiB;
constexpr size_t WS_END = 305 * MiB;
constexpr size_t O_Y = 0, O_KWIN = 16908288, O_VWIN = 16973824, O_HSP = 17039360, O_KNEW = 17104896, O_VNEW = 17137664, O_GV = 17170432, O_HSS = 17235968;

constexpr int LDS_BYTES = 147456;
constexpr int NPH = 26;

#define LAS __attribute__((address_space(3)))
typedef unsigned short bf16_t;
typedef short bf16x8 __attribute__((ext_vector_type(8)));
typedef float f32x4 __attribute__((ext_vector_type(4)));
typedef unsigned u32x4 __attribute__((ext_vector_type(4)));
typedef unsigned u32x2 __attribute__((ext_vector_type(2)));

__device__ __forceinline__ float bf2f(unsigned h) { return __uint_as_float(h << 16); }
__device__ __forceinline__ unsigned f2bf(float f) { unsigned u = __float_as_uint(f); return (u + 0x7fffu + ((u >> 16) & 1u)) >> 16; }
__device__ __forceinline__ unsigned pk2(float lo, float hi) { return f2bf(lo) | (f2bf(hi) << 16); }
__device__ __forceinline__ void unpack8(const u32x4 w, float* x) {
    x[0] = __uint_as_float(w.x << 16); x[1] = __uint_as_float(w.x & 0xffff0000u); x[2] = __uint_as_float(w.y << 16); x[3] = __uint_as_float(w.y & 0xffff0000u);
    x[4] = __uint_as_float(w.z << 16); x[5] = __uint_as_float(w.z & 0xffff0000u); x[6] = __uint_as_float(w.w << 16); x[7] = __uint_as_float(w.w & 0xffff0000u);
}
__device__ __forceinline__ u32x4 pack8(const float* x) { u32x4 w; w.x = pk2(x[0], x[1]); w.y = pk2(x[2], x[3]); w.z = pk2(x[4], x[5]); w.w = pk2(x[6], x[7]); return w; }
__device__ __forceinline__ float sigmoid_f(float x) { return 1.0f / (1.0f + __expf(-x)); }
__device__ __forceinline__ float silu2(float x) { return x * __builtin_amdgcn_rcpf(1.0f + __expf(-x)); }
__device__ __forceinline__ float wave_sum(float v) {
#pragma unroll
    for (int o = 1; o < 64; o <<= 1) v += __shfl_xor(v, o);
    return v;
}
__device__ __forceinline__ float wave_max(float v) {
#pragma unroll
    for (int o = 1; o < 64; o <<= 1) v = fmaxf(v, __shfl_xor(v, o));
    return v;
}

struct Args { const float* in[24]; float* out; unsigned char* ws; int ph_lo, ph_hi; };

struct Ctx {
    LAS unsigned char* lds;
    int tid, lane, wave, G, bid;
    const float* const* in;
    float* out; unsigned char* ws;
};
#define IN(i) (C.in[i])
#define WSP(T, off) ((T*)(C.ws + (off)))

__device__ __forceinline__ void transpose_item(const float* W, int K, int N, bf16_t* WT, int k0, int n0, int drow, LAS float* scr, int lane) {
    f32x4 v[16];
    const float* src = W + (size_t)(k0 + (lane >> 4)) * N + n0 + (lane & 15) * 4;
#pragma unroll
    for (int i = 0; i < 16; ++i) v[i] = *(const f32x4*)(src + (size_t)(4 * i) * N);
#pragma unroll
    for (int i = 0; i < 16; ++i) { LAS float* d = scr + (4 * i + (lane >> 4)) * 65 + (lane & 15) * 4; d[0] = v[i].x; d[1] = v[i].y; d[2] = v[i].z; d[3] = v[i].w; }
    asm volatile("s_waitcnt lgkmcnt(0)" ::: "memory");
    const int c = lane & 7;
#pragma unroll
    for (int j = 0; j < 8; ++j) { const int n = (lane >> 3) + 8 * j; const LAS float* s = scr + (8 * c) * 65 + n;
        u32x4 o; o.x = pk2(s[0 * 65], s[1 * 65]); o.y = pk2(s[2 * 65], s[3 * 65]); o.z = pk2(s[4 * 65], s[5 * 65]); o.w = pk2(s[6 * 65], s[7 * 65]);
        *(u32x4*)(WT + (size_t)(drow + n) * K + k0 + 8 * c) = o; }
    asm volatile("s_waitcnt lgkmcnt(0)" ::: "memory");
}
constexpr int N_TR_LAYER = 2 * 16 * 88 + 2 * 44 * 16 + 16 * 36 + 16 * 16;
__device__ __forceinline__ void transpose_dispatch(const Ctx& C, int l, int it) {
    LAS float* scr = (LAS float*)(C.lds + C.wave * 16640);
    constexpr int I_FI = 16 * 88, I_FO = 44 * 16, I_WI = 16 * 36, I_WO = 16 * 16;
    int r = it;
    if (r < 2 * I_FI) { const int f = r / I_FI, q = r % I_FI, mi = l * 2 + f; const int kb = q / 88, nb = q % 88, n0 = nb * 64;
        const int half = n0 >= DFF ? 1 : 0, j0 = n0 - half * DFF, drow = 256 * (j0 >> 7) + 128 * half + (j0 & 127);
        transpose_item(IN(f ? 18 : 16) + (size_t)l * DM * 2 * DFF, DM, 2 * DFF, WSP(bf16_t, WS_FFIN) + (size_t)mi * 2 * DFF * DM, kb * 64, n0, drow, scr, C.lane); return; }
    r -= 2 * I_FI;
    if (r < 2 * I_FO) { const int f = r / I_FO, q = r % I_FO, mi = l * 2 + f; const int kb = q / 16, nb = q % 16;
        transpose_item(IN(f ? 19 : 17) + (size_t)l * DFF * DM, DFF, DM, WSP(bf16_t, WS_FFOUT) + (size_t)mi * DM * DFF, kb * 64, nb * 64, nb * 64, scr, C.lane); return; }
    r -= 2 * I_FO;
    if (r < I_WI) { const int q = r; const int kb = q / 36, nb = q % 36;
        transpose_item(IN(7) + (size_t)l * DM * DIN, DM, DIN, WSP(bf16_t, WS_WIN) + (size_t)l * DIN * DM, kb * 64, nb * 64, nb * 64, scr, C.lane); return; }
    r -= I_WI;
    if (r < I_WO) { const int q = r; const int kb = q / 16, nb = q % 16;
        transpose_item(IN(8) + (size_t)l * DM * DM, DM, DM, WSP(bf16_t, WS_WOUT) + (size_t)l * DM * DM, kb * 64, nb * 64, nb * 64, scr, C.lane); }
}
__device__ __forceinline__ void ada_item(const Ctx& C, int item) {
    LAS bf16_t* As = (LAS bf16_t*)C.lds;
    const int l = item / 72, n0 = (item % 72) * 128 + C.wave * 16, lane = C.lane, fr = lane & 15, fq = lane >> 4;
    const float* W = IN(20) + (size_t)l * DM * MODW + n0 + fr;
    f32x4 acc[9];
#pragma unroll
    for (int i = 0; i < 9; ++i) acc[i] = (f32x4){0.f, 0.f, 0.f, 0.f};
#pragma unroll 1
    for (int kc = 0; kc < 4; ++kc) {
        __syncthreads();
        for (int e = C.tid; e < 144 * 32; e += 512) { const int r = e >> 5, k8 = (e & 31) * 8; u32x4 w = (u32x4){0u, 0u, 0u, 0u};
            if (r < NCROW) { const float* cp = (r < 2 ? IN(5) + (size_t)r * DM : IN(6) + (size_t)(r - 2) * DM) + kc * 256 + k8;
                const f32x4 a = *(const f32x4*)cp, b = *(const f32x4*)(cp + 4);
                w.x = pk2(silu2(a.x), silu2(a.y)); w.y = pk2(silu2(a.z), silu2(a.w)); w.z = pk2(silu2(b.x), silu2(b.y)); w.w = pk2(silu2(b.z), silu2(b.w)); }
            *(LAS u32x4*)(As + r * 264 + k8) = w; }
        __syncthreads();
        const float* Wk = W + (size_t)(kc * 256 + fq * 8) * MODW;
#pragma unroll 4
        for (int ks = 0; ks < 8; ++ks) {
            float bv[8];
#pragma unroll
            for (int j = 0; j < 8; ++j) bv[j] = Wk[(size_t)(ks * 32 + j) * MODW];
            const bf16x8 bf = __builtin_bit_cast(bf16x8, pack8(bv));
#pragma unroll
            for (int mt = 0; mt < 9; ++mt) { const bf16x8 av = *(const LAS bf16x8*)(As + (mt * 16 + fr) * 264 + ks * 32 + fq * 8);
                acc[mt] = __builtin_amdgcn_mfma_f32_16x16x32_bf16(av, bf, acc[mt], 0, 0, 0); }
        }
    }
    const float bias = IN(21)[l * MODW + n0 + fr];
    float* mo = WSP(float, WS_MOD) + (size_t)l * NCROW * MODW + n0 + fr;
#pragma unroll
    for (int mt = 0; mt < 9; ++mt)
#pragma unroll
        for (int i = 0; i < 4; ++i) { const int r = mt * 16 + fq * 4 + i; if (r < NCROW) mo[(size_t)r * MODW] = acc[mt][i] + bias; }
}
__device__ __forceinline__ void phase_prologue(const Ctx& C, int rep = 0) {
    {
        float* rt = WSP(float, WS_ROPE);
        for (int e = C.bid * 512 + C.tid; e < 8193 * 8; e += C.G * 512) {
            const int p = e >> 3, i = e & 7; const int pos = (p == 8192) ? 16384 : p;
            const float invf = exp2f(-(float)i * 2.3664460711655217f);
            const double rev = (double)pos * (double)invf * 0.15915494309189535;
            const float r = (float)((rev - rint(rev)) * 6.283185307179586);
            rt[p * 16 + i] = __cosf(r); rt[p * 16 + 8 + i] = __sinf(r);
        }
    }
    unsigned* ctr = WSP(unsigned, 0) + rep * 64;
    volatile LAS int* sitem = (volatile LAS int*)(C.lds + LDS_BYTES - 16);
    for (;;) {
        __syncthreads();
        if (C.tid == 0) *sitem = (int)atomicAdd(ctr, 1u);
        __syncthreads();
        const int it = *sitem;
        if (it >= 144 + 2 * (N_TR_LAYER / 8)) break;
        if (it < 144) ada_item(C, it); else { const int q = it - 144; transpose_dispatch(C, q / (N_TR_LAYER / 8), (q % (N_TR_LAYER / 8)) * 8 + C.wave); }
    }
}

__device__ __forceinline__ void phase_mod0(const Ctx& C) {
    const int gw = C.bid * 8 + C.wave, NGW = C.G * 8;
    const float* mod = WSP(float, WS_MOD);
#define ROWSRC(r) ((r) < MP ? IN(0) + (size_t)(r) * DM : IN(1) + (size_t)((r) - MP) * DM)
    f32x4 nx[4];
    if (gw < MR) { const float* xs = ROWSRC(gw);
#pragma unroll
        for (int j = 0; j < 4; ++j) nx[j] = *(const f32x4*)(xs + 4 * C.lane + 256 * j); }
    for (int r = gw; r < MR; r += NGW) {
        f32x4 x[4];
#pragma unroll
        for (int j = 0; j < 4; ++j) x[j] = nx[j];
        const int rn = r + NGW;
        if (rn < MR) { const float* xs = ROWSRC(rn);
#pragma unroll
            for (int j = 0; j < 4; ++j) nx[j] = *(const f32x4*)(xs + 4 * C.lane + 256 * j); }
        const float* mp = mod + (size_t)crow_of(r) * MODW;
        bf16_t* ho = WSP(bf16_t, WS_H) + (size_t)r * DM;
#pragma unroll
        for (int j = 0; j < 4; ++j) { const int c = 4 * C.lane + 256 * j;
            const f32x4 sh = *(const f32x4*)(mp + c), sc = *(const f32x4*)(mp + DM + c);
            const f32x4 h = x[j] * (sc + 1.0f) + sh;
            u32x2 w; w.x = pk2(h.x, h.y); w.y = pk2(h.z, h.w); *(u32x2*)(ho + c) = w; }
    }
#undef ROWSRC
}

__device__ __forceinline__ void ln_finish(const Ctx& C, int r, float (&v)[2][8], const f32x4 (&gv)[2][2], const f32x4 (&bv)[2][2], const float* mp, bool last, float* ST) {
    float s = 0.f;
#pragma unroll
    for (int j = 0; j < 2; ++j)
#pragma unroll
        for (int e = 0; e < 8; ++e) s += v[j][e];
    const float mean = wave_sum(s) * (1.0f / DM); float s2 = 0.f;
#pragma unroll
    for (int j = 0; j < 2; ++j)
#pragma unroll
        for (int e = 0; e < 8; ++e) { v[j][e] -= mean; s2 += v[j][e] * v[j][e]; }
    const float rstd = 1.0f / sqrtf(wave_sum(s2) * (1.0f / DM) + 1e-5f);
    if (!last && C.lane == 0) { ST[2 * r] = mean; ST[2 * r + 1] = rstd; }
#pragma unroll
    for (int j = 0; j < 2; ++j) { const int c = 8 * C.lane + 512 * j;
        float y[8];
#pragma unroll
        for (int e = 0; e < 8; ++e) y[e] = v[j][e] * rstd * gv[j][e >> 2][e & 3] + bv[j][e >> 2][e & 3];
        if (last) { float* yo = C.out + (size_t)r * DM + c; *(f32x4*)yo = (f32x4){y[0], y[1], y[2], y[3]}; *(f32x4*)(yo + 4) = (f32x4){y[4], y[5], y[6], y[7]}; }
        else { const f32x4 sh0 = *(const f32x4*)(mp + c), sh1 = *(const f32x4*)(mp + c + 4), sc0 = *(const f32x4*)(mp + DM + c), sc1 = *(const f32x4*)(mp + DM + c + 4);
            float h[8];
#pragma unroll
            for (int e = 0; e < 8; ++e) h[e] = y[e] * ((e < 4 ? sc0[e & 3] : sc1[e & 3]) + 1.0f) + (e < 4 ? sh0[e & 3] : sh1[e & 3]);
            *(u32x4*)(WSP(bf16_t, WS_H) + (size_t)r * DM + c) = pack8(h); }
    }
}
__device__ __forceinline__ void phase_ln(const Ctx& C, int l, int which, int rep = 0) {
    const int gw = C.bid * 8 + C.wave, NGW = C.G * 8;
    const int li = l * 3 + which;
    const float* g = IN(22) + (size_t)li * DM; const float* bb = IN(23) + (size_t)li * DM;
    const bool has_prev = (li > 0), last = (li == 3 * DEPTH - 1);
    const float* pg = IN(22) + (size_t)(has_prev ? li - 1 : 0) * DM; const float* pb = IN(23) + (size_t)(has_prev ? li - 1 : 0) * DM;
    int ml = l, si = (which == 0) ? 3 : 6;
    if (which == 2) { ml = l + 1; si = 0; }
    const float* mod = WSP(float, WS_MOD) + (size_t)(last ? 0 : ml) * NCROW * MODW + (size_t)si * DM;
    const float* gatep = WSP(float, WS_MOD) + (size_t)l * NCROW * MODW + (size_t)(which == 0 ? 2 : which == 1 ? 5 : 8) * DM;
    const float rscale = (which == 1) ? 1.0f : 0.5f;
    float* ST = WSP(float, WS_ST);
    bf16_t* XB = WSP(bf16_t, WS_XB);
    f32x4 gv[2][2], bv[2][2];
#pragma unroll
    for (int j = 0; j < 2; ++j)
#pragma unroll
        for (int q = 0; q < 2; ++q) { gv[j][q] = *(const f32x4*)(g + 8 * C.lane + 512 * j + 4 * q); bv[j][q] = *(const f32x4*)(bb + 8 * C.lane + 512 * j + 4 * q); }
    {
        u32x4 nv[2];
        if (gw < MP) { nv[0] = *(const u32x4*)(XB + (size_t)gw * DM + 8 * C.lane); nv[1] = *(const u32x4*)(XB + (size_t)gw * DM + 8 * C.lane + 512); }
        for (int r = gw; r < MP; r += NGW) {
            float v[2][8]; unpack8(nv[0], v[0]); unpack8(nv[1], v[1]);
            const int rn = r + NGW;
            if (rn < MP) { nv[0] = *(const u32x4*)(XB + (size_t)rn * DM + 8 * C.lane); nv[1] = *(const u32x4*)(XB + (size_t)rn * DM + 8 * C.lane + 512); }
            ln_finish(C, r, v, gv, bv, mod + (size_t)(r >> 13) * MODW, last, ST);
        }
    }
    for (int r = MP + gw; r < MR && rep == 0; r += NGW) {
        float v[2][8];
        float pm = 0.f, pr = 1.f; if (has_prev) { pm = ST[2 * r]; pr = ST[2 * r + 1]; }
        const float* ys = WSP(float, WS_YS) + (size_t)(r - MP) * DM; const float* gp = gatep + (size_t)crow_of(r) * MODW;
#pragma unroll
        for (int j = 0; j < 2; ++j) { const int c = 8 * C.lane + 512 * j;
            float x[8];
            if (has_prev) { unpack8(*(const u32x4*)(XB + (size_t)r * DM + c), x);
#pragma unroll
                for (int e = 0; e < 8; ++e) x[e] = (x[e] - pm) * pr * pg[c + e] + pb[c + e]; }
            else { const float* xs = IN(1) + (size_t)(r - MP) * DM + c;
#pragma unroll
                for (int e = 0; e < 8; ++e) x[e] = xs[e]; }
#pragma unroll
            for (int e = 0; e < 8; ++e) { const float y = (ys[c + e] + ys[131072 + c + e]) + (ys[262144 + c + e] + ys[393216 + c + e]);
                v[j][e] = x[e] * ALPHA_F + (gp[c + e] + 1.0f) * (y * rscale); }
            if (!last) { const u32x4 w = pack8(v[j]); *(u32x4*)(XB + (size_t)r * DM + c) = w; unpack8(w, v[j]); }
        }
        ln_finish(C, r, v, gv, bv, mod + (size_t)crow_of(r) * MODW, last, ST);
    }
}

__device__ __forceinline__ int vperm(int key) { return (key & ~31) | (((key >> 2) & 3) << 3) | (((key >> 4) & 1) << 2) | (key & 3); }
__device__ __forceinline__ void attn_prompt_item(const Ctx& C, int l, int item) {
    const int b = item >> 7, blk = (item >> 1) & 63, kvh = item & 1;
    LAS bf16_t* Ks = (LAS bf16_t*)C.lds;
    LAS bf16_t* Vt = (LAS bf16_t*)(C.lds + 36864);
    const bf16_t* P = WSP(bf16_t, WS_PROJ) + (size_t)b * SEQ * DIN;
    const float* rope = WSP(float, WS_ROPE);
    u32x4 qpre0[4], qpre1[4]; f32x4 rcs[4][4];
    {   const int fr_ = C.lane & 15, fq_ = C.lane >> 4, hq_ = kvh * 4 + (C.wave >> 1);
#pragma unroll
        for (int st = 0; st < 4; ++st) { const int t_ = blk * 128 + ((C.wave & 1) * 4 + st) * 16 + fr_; const bf16_t* qp = P + (size_t)t_ * DIN + hq_ * 64;
            qpre0[st] = *(const u32x4*)(qp + fq_ * 8); qpre1[st] = *(const u32x4*)(qp + 32 + fq_ * 8);
            const float* rr = rope + (size_t)t_ * 16; rcs[st][0] = *(const f32x4*)rr; rcs[st][1] = *(const f32x4*)(rr + 4); rcs[st][2] = *(const f32x4*)(rr + 8); rcs[st][3] = *(const f32x4*)(rr + 12); } }
    __syncthreads();
    {
        const int seg = C.tid & 7, key0 = C.tid >> 3;
#pragma unroll 1
        for (int hb = 0; hb < 2; ++hb) {
            u32x4 kwv[2], vwv[2], owv[2]; f32x4 rc[2][4];
#pragma unroll
            for (int j = 0; j < 2; ++j) { const int key = key0 + 64 * (2 * hb + j), t = (blk - 1) * 128 + key;
                kwv[j] = (u32x4){0u, 0u, 0u, 0u}; vwv[j] = kwv[j]; owv[j] = kwv[j];
#pragma unroll
                for (int q = 0; q < 4; ++q) rc[j][q] = (f32x4){0.f, 0.f, 0.f, 0.f};
                if (t >= 0) { const bf16_t* rp = P + (size_t)t * DIN;
                    kwv[j] = *(const u32x4*)(rp + 512 + kvh * 64 + seg * 8); vwv[j] = *(const u32x4*)(rp + 640 + kvh * 64 + seg * 8);
                    if (seg < 2) { owv[j] = *(const u32x4*)(rp + 512 + kvh * 64 + (seg ^ 1) * 8); const float* rr = rope + (size_t)t * 16;
                        rc[j][0] = *(const f32x4*)rr; rc[j][1] = *(const f32x4*)(rr + 4); rc[j][2] = *(const f32x4*)(rr + 8); rc[j][3] = *(const f32x4*)(rr + 12); } } }
#pragma unroll
            for (int j = 0; j < 2; ++j) { const int key = key0 + 64 * (2 * hb + j);
                u32x4 kw = kwv[j]; float kf[8], vf[8];
                if (seg < 2) { float of[8]; unpack8(kw, kf); unpack8(owv[j], of);
#pragma unroll
                    for (int e = 0; e < 8; ++e) { const float cs = rc[j][e >> 2][e & 3], sn = rc[j][2 + (e >> 2)][e & 3]; kf[e] = (seg == 0) ? (kf[e] * cs - of[e] * sn) : (kf[e] * cs + of[e] * sn); }
                    kw = pack8(kf); }
                *(LAS u32x4*)(Ks + key * 72 + seg * 8) = kw;
                unpack8(vwv[j], vf);
                const int pk = vperm(key);
#pragma unroll
                for (int e = 0; e < 8; ++e) Vt[(seg * 8 + e) * 264 + pk] = (bf16_t)(__float_as_uint(vf[e]) >> 16);
                if (blk == 63 && key >= 128) {
                    unpack8(kw, kf);
                    const size_t o = ((size_t)((l * 2 + b) * 128 + (key - 128)) * 2 + kvh) * 64 + seg * 8;
                    *(f32x4*)(C.out + O_KWIN + o) = (f32x4){kf[0], kf[1], kf[2], kf[3]}; *(f32x4*)(C.out + O_KWIN + o + 4) = (f32x4){kf[4], kf[5], kf[6], kf[7]};
                    *(f32x4*)(C.out + O_VWIN + o) = (f32x4){vf[0], vf[1], vf[2], vf[3]}; *(f32x4*)(C.out + O_VWIN + o + 4) = (f32x4){vf[4], vf[5], vf[6], vf[7]};
                }
            }
        }
    }
    __syncthreads();
    const int w = C.wave, lane = C.lane, fr = lane & 15, fq = lane >> 4;
    const int hq = kvh * 4 + (w >> 1);
    const float sink = IN(9)[l * 8 + hq];
    bf16_t* MIX = WSP(bf16_t, WS_MIX) + (size_t)b * SEQ * DM;
#pragma unroll
    for (int st = 0; st < 4; ++st) {
        const int isub = (w & 1) * 4 + st; const int t = blk * 128 + isub * 16 + fr;
        u32x4 q0w = qpre0[st]; const u32x4 q1w = qpre1[st];
        {
            float x[8], o[8]; unpack8(q0w, x);
#pragma unroll
            for (int e = 0; e < 8; ++e) o[e] = __shfl_xor(x[e], 16);
            if (fq < 2) {
#pragma unroll
                for (int e = 0; e < 8; ++e) { const float cs = rcs[st][e >> 2][e & 3], sn = rcs[st][2 + (e >> 2)][e & 3]; x[e] = (fq == 0) ? (x[e] * cs - o[e] * sn) : (x[e] * cs + o[e] * sn); }
                q0w = pack8(x);
            }
        }
        const bf16x8 q0 = __builtin_bit_cast(bf16x8, q0w), q1 = __builtin_bit_cast(bf16x8, q1w);
        const int kbase = 32 * (isub >> 1);
        f32x4 s[10];
#pragma unroll
        for (int j = 0; j < 10; ++j) {
            const LAS bf16_t* kp = Ks + (kbase + 16 * j + fr) * 72 + fq * 8;
            const bf16x8 a0 = *(const LAS bf16x8*)kp, a1 = *(const LAS bf16x8*)(kp + 32);
            f32x4 z = (f32x4){0.f, 0.f, 0.f, 0.f};
            z = __builtin_amdgcn_mfma_f32_16x16x32_bf16(a0, q0, z, 0, 0, 0);
            s[j] = __builtin_amdgcn_mfma_f32_16x16x32_bf16(a1, q1, z, 0, 0, 0);
        }
        const int qi = 128 + isub * 16 + fr;
        float mx = sink;
#pragma unroll
        for (int j = 0; j < 10; ++j)
#pragma unroll
            for (int i = 0; i < 4; ++i) { const int kj = kbase + 16 * j + 4 * fq + i;
                const bool valid = (kj <= qi) && (qi - kj < 128) && (blk > 0 || kj >= 128);
                const float v = valid ? s[j][i] * 0.125f : -1e30f; s[j][i] = v; mx = fmaxf(mx, v); }
        mx = fmaxf(mx, __shfl_xor(mx, 16)); mx = fmaxf(mx, __shfl_xor(mx, 32));
        float sum = 0.f;
#pragma unroll
        for (int j = 0; j < 10; ++j)
#pragma unroll
            for (int i = 0; i < 4; ++i) { const float p = __expf(s[j][i] - mx); s[j][i] = p; sum += p; }
        sum += __shfl_xor(sum, 16); sum += __shfl_xor(sum, 32); sum += __expf(sink - mx);
        const float rl = 1.0f / sum;
        f32x4 o[4];
#pragma unroll
        for (int dt = 0; dt < 4; ++dt) o[dt] = (f32x4){0.f, 0.f, 0.f, 0.f};
#pragma unroll
        for (int g = 0; g < 5; ++g) {
            u32x4 pw; pw.x = pk2(s[2 * g][0], s[2 * g][1]); pw.y = pk2(s[2 * g][2], s[2 * g][3]); pw.z = pk2(s[2 * g + 1][0], s[2 * g + 1][1]); pw.w = pk2(s[2 * g + 1][2], s[2 * g + 1][3]);
            const bf16x8 pb = __builtin_bit_cast(bf16x8, pw);
#pragma unroll
            for (int dt = 0; dt < 4; ++dt) {
                const bf16x8 av = *(const LAS bf16x8*)(Vt + (dt * 16 + fr) * 264 + kbase + 32 * g + fq * 8);
                o[dt] = __builtin_amdgcn_mfma_f32_16x16x32_bf16(av, pb, o[dt], 0, 0, 0);
            }
        }
        bf16_t* op = MIX + (size_t)t * DM + hq * 64 + 4 * fq;
#pragma unroll
        for (int dt = 0; dt < 4; ++dt) { u32x2 wv; wv.x = pk2(o[dt][0] * rl, o[dt][1] * rl); wv.y = pk2(o[dt][2] * rl, o[dt][3] * rl); *(u32x2*)(op + dt * 16) = wv; }
    }
}

__device__ __forceinline__ float hgrn_lb(const Ctx& C, int l, int j) { return l == 0 ? 0.f : sigmoid_f(IN(14)[256 + j] - IN(14)[j]); }
typedef float f32x2 __attribute__((ext_vector_type(2)));
#define LDS_BARRIER() asm volatile("s_waitcnt lgkmcnt(0)\n\ts_barrier" ::: "memory")
__device__ __forceinline__ void hgrn_local_item(const Ctx& C, int l, int pair, int xmode = 0) {
    const int hi = C.tid >> 8, tl = C.tid & 255, wl = (C.tid >> 6) & 3;
    const int chain = pair >> 5, chunk = (pair & 31) * 2 + hi, b = chain >> 2, h = chain & 3, t0 = chunk * 128;
    LAS float* base = (LAS float*)C.lds + hi * 12288;
    LAS float* Fs = base; LAS float* Qt = base + 1024; LAS float* Is = base + 2048; LAS float* Qs = base + 3072; LAS float* Ob = base + 4096;
    const int lane = C.lane, kg = lane >> 3, vp = lane & 7, v0 = 16 * wl + 2 * vp;
    float* HS = WSP(float, WS_HGS) + (size_t)(chain * 64 + chunk) * 4096;
    f32x2 Sa[4], Sb2[4], D2[4];
#pragma unroll
    for (int j = 0; j < 4; ++j) { Sa[j] = (f32x2){0.f, 0.f}; Sb2[j] = (f32x2){0.f, 0.f}; D2[j] = (f32x2){1.f, 1.f}; }
    const int tt = tl >> 4, c4 = (tl & 15) * 4;
    f32x4 lbv;
    lbv.x = hgrn_lb(C, l, h * 64 + c4); lbv.y = hgrn_lb(C, l, h * 64 + c4 + 1); lbv.z = hgrn_lb(C, l, h * 64 + c4 + 2); lbv.w = hgrn_lb(C, l, h * 64 + c4 + 3);
    const bf16_t* P = WSP(bf16_t, WS_PROJ) + (size_t)(b * SEQ + t0) * DIN + h * 64 + c4;
    const bool qwriter = (wl == 0 && vp == 0);
    u32x2 pf, pi, pq;
    { const bf16_t* rp = P + (size_t)tt * DIN; pf = *(const u32x2*)(rp + 1536); pi = *(const u32x2*)(rp + 1792); pq = *(const u32x2*)(rp + 1280); }
#define HG_FLUSH(sub_) do { const size_t row = (size_t)(b * SEQ + t0 + (sub_) * 16 + tt); float o0 = 0.f, o1 = 0.f, o2 = 0.f, o3 = 0.f; \
        const LAS float* p0 = Ob + tt * 512 + c4 * 8; \
        _Pragma("unroll") for (int i = 0; i < 8; ++i) { const int c = (i + tl) & 7; const f32x4 pv = *(const LAS f32x4*)(p0 + c * 4); const float sv = (pv.x + pv.y) + (pv.z + pv.w); const int e = c >> 1; \
            o0 += (e == 0) ? sv : 0.f; o1 += (e == 1) ? sv : 0.f; o2 += (e == 2) ? sv : 0.f; o3 += (e == 3) ? sv : 0.f; } \
        *(f32x4*)(WSP(float, WS_OL) + row * 256 + h * 64 + c4) = (f32x4){o0, o1, o2, o3}; \
        const f32x4 qd = *(const LAS f32x4*)(Qt + tt * 64 + c4); u32x2 qw; qw.x = pk2(qd.x, qd.y); qw.y = pk2(qd.z, qd.w); \
        *(u32x2*)(WSP(bf16_t, WS_QT) + row * 256 + h * 64 + c4) = qw; } while (0)
#pragma unroll 1
    for (int sub = 0; sub < 8; ++sub) {
        LDS_BARRIER();
        const u32x2 cpf = pf, cpi = pi, cpq = pq;
        if (sub < 7) { const bf16_t* rp = P + (size_t)((sub + 1) * 16 + tt) * DIN; pf = *(const u32x2*)(rp + 1536); pi = *(const u32x2*)(rp + 1792); pq = *(const u32x2*)(rp + 1280); }
        if (sub > 0 && xmode == 0) HG_FLUSH(sub - 1);
        {
            const float cf[4] = {bf2f(cpf.x & 0xffffu), bf2f(cpf.x >> 16), bf2f(cpf.y & 0xffffu), bf2f(cpf.y >> 16)};
            f32x4 f;
            f.x = lbv.x + (1.0f - lbv.x) * __builtin_amdgcn_rcpf(1.0f + __expf(-cf[0])); f.y = lbv.y + (1.0f - lbv.y) * __builtin_amdgcn_rcpf(1.0f + __expf(-cf[1]));
            f.z = lbv.z + (1.0f - lbv.z) * __builtin_amdgcn_rcpf(1.0f + __expf(-cf[2])); f.w = lbv.w + (1.0f - lbv.w) * __builtin_amdgcn_rcpf(1.0f + __expf(-cf[3]));
            *(LAS f32x4*)(Fs + tt * 64 + c4) = f;
            *(LAS f32x4*)(Is + tt * 64 + c4) = (f32x4){bf2f(cpi.x & 0xffffu), bf2f(cpi.x >> 16), bf2f(cpi.y & 0xffffu), bf2f(cpi.y >> 16)};
            *(LAS f32x4*)(Qs + tt * 64 + c4) = (f32x4){bf2f(cpq.x & 0xffffu), bf2f(cpq.x >> 16), bf2f(cpq.y & 0xffffu), bf2f(cpq.y >> 16)};
        }
        LDS_BARRIER();
        if (xmode != 2) {
            const LAS float* fp = Fs + kg * 8; const LAS float* ip = Is + v0; const LAS float* qp = Qs + kg * 8; LAS float* op = Ob + v0 * 8 + kg; LAS float* qtp = Qt + kg * 8;
            f32x4 fa_n = *(const LAS f32x4*)fp, fb_n = *(const LAS f32x4*)(fp + 4), qa_n = *(const LAS f32x4*)qp, qb_n = *(const LAS f32x4*)(qp + 4); f32x2 iv_n = *(const LAS f32x2*)ip;
#pragma unroll
            for (int t = 0; t < 16; ++t) {
                const f32x4 fa = fa_n, fb = fb_n, qa = qa_n, qb = qb_n; const f32x2 ivv = iv_n;
                if (t < 15) { fa_n = *(const LAS f32x4*)(fp + (t + 1) * 64); fb_n = *(const LAS f32x4*)(fp + (t + 1) * 64 + 4); iv_n = *(const LAS f32x2*)(ip + (t + 1) * 64);
                    qa_n = *(const LAS f32x4*)(qp + (t + 1) * 64); qb_n = *(const LAS f32x4*)(qp + (t + 1) * 64 + 4); }
                const f32x2 ia = (f32x2){ivv.x, ivv.x}, ib = (f32x2){ivv.y, ivv.y};
                Sa[0] = ia + fa.xy * (Sa[0] - ia); Sa[1] = ia + fa.zw * (Sa[1] - ia); Sa[2] = ia + fb.xy * (Sa[2] - ia); Sa[3] = ia + fb.zw * (Sa[3] - ia);
                Sb2[0] = ib + fa.xy * (Sb2[0] - ib); Sb2[1] = ib + fa.zw * (Sb2[1] - ib); Sb2[2] = ib + fb.xy * (Sb2[2] - ib); Sb2[3] = ib + fb.zw * (Sb2[3] - ib);
                D2[0] *= fa.xy; D2[1] *= fa.zw; D2[2] *= fb.xy; D2[3] *= fb.zw;
                const f32x2 oa = qa.xy * Sa[0] + qa.zw * Sa[1] + qb.xy * Sa[2] + qb.zw * Sa[3];
                const f32x2 ob = qa.xy * Sb2[0] + qa.zw * Sb2[1] + qb.xy * Sb2[2] + qb.zw * Sb2[3];
                op[t * 512] = oa.x + oa.y; op[t * 512 + 8] = ob.x + ob.y;
                if (qwriter) { const f32x2 q0 = qa.xy * D2[0], q1 = qa.zw * D2[1], q2 = qb.xy * D2[2], q3 = qb.zw * D2[3];
                    *(LAS f32x4*)(qtp + t * 64) = (f32x4){q0.x, q0.y, q1.x, q1.y}; *(LAS f32x4*)(qtp + t * 64 + 4) = (f32x4){q2.x, q2.y, q3.x, q3.y}; }
            }
        }
    }
    LDS_BARRIER();
    if (xmode == 0) HG_FLUSH(7);
#undef HG_FLUSH
    if (xmode != 0) return;
#pragma unroll
    for (int j = 0; j < 4; ++j) { float* p0 = HS + (kg * 8 + 2 * j) * 64 + v0; *(f32x2*)p0 = (f32x2){Sa[j].x, Sb2[j].x}; *(f32x2*)(p0 + 64) = (f32x2){Sa[j].y, Sb2[j].y}; }
    if (qwriter) {
        float* HD = WSP(float, WS_HGD) + (size_t)(chain * 64 + chunk) * 64 + kg * 8;
#pragma unroll
        for (int j = 0; j < 4; ++j) { HD[2 * j] = D2[j].x; HD[2 * j + 1] = D2[j].y; }
    }
}
__device__ __forceinline__ void hgrn_corr_item(const Ctx& C, int l, int pair) {
    const int hi = C.tid >> 8, tl = C.tid & 255, wl = (C.tid >> 6) & 3;
    const int chain = pair >> 5, chunk = (pair & 31) * 2 + hi, b = chain >> 2, h = chain & 3, t0 = chunk * 128;
    LAS bf16_t* Sb = (LAS bf16_t*)C.lds + hi * (64 * 72);
    const float* HS = WSP(float, WS_HGS) + (size_t)(chain * 64 + chunk) * 4096;
    const int lane = C.lane, fr = lane & 15, fq = lane >> 4;
    const size_t row0 = (size_t)(b * SEQ + t0 + wl * 32);
    u32x4 qa[2][2];
#pragma unroll
    for (int mt = 0; mt < 2; ++mt)
#pragma unroll
        for (int ks = 0; ks < 2; ++ks) qa[mt][ks] = *(const u32x4*)(WSP(bf16_t, WS_QT) + (row0 + mt * 16 + fr) * 256 + h * 64 + ks * 32 + fq * 8);
    __syncthreads();
    if (chunk > 0) {
        const int k = tl >> 2, vb = (tl & 3) * 16;
#pragma unroll
        for (int q = 0; q < 4; ++q) { const f32x4 sv = *(const f32x4*)(HS + k * 64 + vb + 4 * q);
            Sb[(vb + 4 * q) * 72 + k] = (bf16_t)f2bf(sv.x); Sb[(vb + 4 * q + 1) * 72 + k] = (bf16_t)f2bf(sv.y); Sb[(vb + 4 * q + 2) * 72 + k] = (bf16_t)f2bf(sv.z); Sb[(vb + 4 * q + 3) * 72 + k] = (bf16_t)f2bf(sv.w); }
    }
    __syncthreads();
    f32x4 acc[2][4];
#pragma unroll
    for (int mt = 0; mt < 2; ++mt)
#pragma unroll
        for (int nt = 0; nt < 4; ++nt) acc[mt][nt] = (f32x4){0.f, 0.f, 0.f, 0.f};
    if (chunk > 0) {
#pragma unroll
        for (int nt = 0; nt < 4; ++nt)
#pragma unroll
            for (int ks = 0; ks < 2; ++ks) { const bf16x8 bv = *(const LAS bf16x8*)(Sb + (nt * 16 + fr) * 72 + ks * 32 + fq * 8);
#pragma unroll
                for (int mt = 0; mt < 2; ++mt) acc[mt][nt] = __builtin_amdgcn_mfma_f32_16x16x32_bf16(__builtin_bit_cast(bf16x8, qa[mt][ks]), bv, acc[mt][nt], 0, 0, 0); }
    }
    float gnv[4];
#pragma unroll
    for (int nt = 0; nt < 4; ++nt) gnv[nt] = IN(15)[l * 64 + nt * 16 + fr];
#pragma unroll
    for (int mt = 0; mt < 2; ++mt) {
        float ol[4][4], cg[4][4];
#pragma unroll
        for (int i = 0; i < 4; ++i) { const size_t row = row0 + mt * 16 + fq * 4 + i;
#pragma unroll
            for (int nt = 0; nt < 4; ++nt) { ol[i][nt] = WSP(float, WS_OL)[row * 256 + h * 64 + nt * 16 + fr]; cg[i][nt] = bf2f(WSP(bf16_t, WS_PROJ)[row * DIN + 2048 + h * 64 + nt * 16 + fr]); } }
#pragma unroll
        for (int i = 0; i < 4; ++i) { const size_t row = row0 + mt * 16 + fq * 4 + i;
            float o[4], ss = 0.f;
#pragma unroll
            for (int nt = 0; nt < 4; ++nt) { o[nt] = acc[mt][nt][i] + ol[i][nt]; ss += o[nt] * o[nt]; }
            ss += __shfl_xor(ss, 1); ss += __shfl_xor(ss, 2); ss += __shfl_xor(ss, 4); ss += __shfl_xor(ss, 8);
            const float r = __builtin_amdgcn_rsqf(ss * (1.0f / 64.0f) + 1e-6f);
            bf16_t* op = WSP(bf16_t, WS_MIX) + row * DM + 768 + h * 64 + fr;
#pragma unroll
            for (int nt = 0; nt < 4; ++nt) op[nt * 16] = (bf16_t)f2bf(o[nt] * r * gnv[nt] * silu2(cg[i][nt])); }
    }
}
__device__ __forceinline__ void hgrn_scan(const Ctx& C, int l) {
    for (int gid = C.bid * 512 + C.tid; gid < 131072; gid += C.G * 512) {
        const int e = gid >> 2, j = gid & 3, chain = e >> 12, kv = e & 4095, k = kv >> 6;
        float* hs = WSP(float, WS_HGS) + ((size_t)chain * 64 + 16 * j) * 4096 + kv; const float* hd = WSP(float, WS_HGD) + ((size_t)chain * 64 + 16 * j) * 64 + k;
        float vv[16], dd[16];
#pragma unroll
        for (int i = 0; i < 16; ++i) { vv[i] = hs[(size_t)i * 4096]; dd[i] = hd[i * 64]; }
        float A = 1.f, B = 0.f;
#pragma unroll
        for (int i = 0; i < 16; ++i) { B = dd[i] * B + vv[i]; A *= dd[i]; }
        float S = 0.f;
#pragma unroll
        for (int m = 0; m < 3; ++m) { const float Am = __shfl(A, (C.lane & ~3) + m), Bm = __shfl(B, (C.lane & ~3) + m); if (m < j) S = Am * S + Bm; }
#pragma unroll
        for (int i = 0; i < 16; ++i) { hs[(size_t)i * 4096] = S; S = dd[i] * S + vv[i]; }
        if (j == 3) C.out[O_HSP + (size_t)(l * 8 + chain) * 4096 + kv] = S;
    }
}

__device__ __forceinline__ void gmlp_prompt_item(const Ctx& C, int l, int item, bool keepW = false) {
    const int b = item >> 8, n = (item >> 2) & 63, g = item & 3;
    LAS bf16_t* Wb = (LAS bf16_t*)C.lds;
    LAS bf16_t* VnT = Wb + 128 * 136;
    __syncthreads();
    const float* Wg = IN(12) + (size_t)(l * 4 + g) * 128 * 128;
    const bf16_t* P = WSP(bf16_t, WS_PROJ) + (size_t)(b * SEQ + n * 128) * DIN;
    {
        f32x4 wa[4], wb[4];
#pragma unroll
        for (int i = 0; i < 4; ++i) { const int e = C.tid + 512 * i, t = e >> 4, s8 = (e & 15) * 8; wa[i] = (f32x4){0.f, 0.f, 0.f, 0.f}; wb[i] = wa[i];
            if (!keepW) { wa[i] = *(const f32x4*)(Wg + t * 128 + s8); wb[i] = *(const f32x4*)(Wg + t * 128 + s8 + 4); } }
        const int s = C.tid >> 2, q4 = C.tid & 3;
        const bf16_t* gp = P + (size_t)s * DIN + 1024 + q4 * 64;
        u32x4 xr[8];
#pragma unroll
        for (int i = 0; i < 8; ++i) xr[i] = *(const u32x4*)(gp + i * 8);
        const bf16_t* gg = P + (size_t)s * DIN + 1024 + g * 64 + q4 * 16;
        const u32x4 y0 = *(const u32x4*)gg, y1 = *(const u32x4*)(gg + 8);
        f32x4 lgv[4], lbv4[4];
#pragma unroll
        for (int i = 0; i < 4; ++i) { lgv[i] = *(const f32x4*)(IN(10) + l * 256 + g * 64 + q4 * 16 + 4 * i); lbv4[i] = *(const f32x4*)(IN(11) + l * 256 + g * 64 + q4 * 16 + 4 * i); }
#pragma unroll
        for (int i = 0; i < 4; ++i) { const int e = C.tid + 512 * i, t = e >> 4, s8 = (e & 15) * 8;
            float w[8] = {wa[i].x, wa[i].y, wa[i].z, wa[i].w, wb[i].x, wb[i].y, wb[i].z, wb[i].w};
#pragma unroll
            for (int j = 0; j < 8; ++j) if (s8 + j > t) w[j] = 0.f;
            if (!keepW) *(LAS u32x4*)(Wb + t * 136 + s8) = pack8(w); }
        float sm = 0.f, sq = 0.f;
#pragma unroll
        for (int i = 0; i < 8; ++i) { float x[8]; unpack8(xr[i], x);
#pragma unroll
            for (int e = 0; e < 8; ++e) { sm += x[e]; sq += x[e] * x[e]; } }
        sm += __shfl_xor(sm, 1); sm += __shfl_xor(sm, 2); sq += __shfl_xor(sq, 1); sq += __shfl_xor(sq, 2);
        const float mean = sm * (1.0f / 256.0f);
        const float var = fmaxf(sq * (1.0f / 256.0f) - mean * mean, 0.f);
        const float rstd = 1.0f / sqrtf(var + 1e-5f);
        float x[16]; unpack8(y0, x); unpack8(y1, x + 8);
#pragma unroll
        for (int i = 0; i < 16; ++i) VnT[(q4 * 16 + i) * 136 + s] = (bf16_t)f2bf((x[i] - mean) * rstd * lgv[i >> 2][i & 3] + lbv4[i >> 2][i & 3]);
    }
    __syncthreads();
    {
        const int w = C.wave, lane = C.lane, fr = lane & 15, fq = lane >> 4;
        f32x4 acc[4];
#pragma unroll
        for (int ct = 0; ct < 4; ++ct) acc[ct] = (f32x4){0.f, 0.f, 0.f, 0.f};
        const float* bsp = IN(13) + (l * 4 + g) * 128 + w * 16 + fq * 4;
        const f32x4 bias4 = *(const f32x4*)bsp;
        bf16_t uu[4][4];
#pragma unroll
        for (int i = 0; i < 4; ++i)
#pragma unroll
            for (int ct = 0; ct < 4; ++ct) uu[i][ct] = P[(size_t)(w * 16 + fq * 4 + i) * DIN + 768 + g * 64 + fr + ct * 16];
        const int nks = (w >> 1) + 1;
        for (int ks = 0; ks < nks; ++ks) {
            const bf16x8 av = *(const LAS bf16x8*)(Wb + (w * 16 + fr) * 136 + ks * 32 + fq * 8);
#pragma unroll
            for (int ct = 0; ct < 4; ++ct) { const bf16x8 bv = *(const LAS bf16x8*)(VnT + (ct * 16 + fr) * 136 + ks * 32 + fq * 8);
                acc[ct] = __builtin_amdgcn_mfma_f32_16x16x32_bf16(av, bv, acc[ct], 0, 0, 0); }
        }
#pragma unroll
        for (int i = 0; i < 4; ++i) { const int t = w * 16 + fq * 4 + i; const float bias = bias4[i];
            bf16_t* op = WSP(bf16_t, WS_MIX) + (size_t)(b * SEQ + n * 128 + t) * DM + 512 + g * 64 + fr;
#pragma unroll
            for (int ct = 0; ct < 4; ++ct) op[ct * 16] = (bf16_t)f2bf(bf2f(uu[i][ct]) * (acc[ct][i] + bias)); }
    }
}

__device__ __forceinline__ void attn_sample_item(const Ctx& C, int l, int b) {
    const int hq = C.wave, lane = C.lane, kvh = hq >> 2;
    LAS float* qs = (LAS float*)C.lds + hq * 128; LAS float* ks = qs + 64;
    const bf16_t* rp = WSP(bf16_t, WS_PROJ) + (size_t)(MP + b) * DIN;
    const float* rr = WSP(float, WS_ROPE) + (size_t)8192 * 16;
    float qd = bf2f(rp[hq * 64 + lane]), kd = bf2f(rp[512 + kvh * 64 + lane]); const float vd = bf2f(rp[640 + kvh * 64 + lane]);
    {
        const float qo = __shfl_xor(qd, 8), ko = __shfl_xor(kd, 8);
        if (lane < 16) { const float cs = rr[lane & 7], sn = rr[8 + (lane & 7)];
            qd = (lane < 8) ? (qd * cs - qo * sn) : (qd * cs + qo * sn); kd = (lane < 8) ? (kd * cs - ko * sn) : (kd * cs + ko * sn); }
    }
    __syncthreads();
    qs[lane] = qd; ks[lane] = kd;
    if ((hq & 3) == 0) { C.out[O_KNEW + (size_t)((l * 128 + b) * 2 + kvh) * 64 + lane] = kd; C.out[O_VNEW + (size_t)((l * 128 + b) * 2 + kvh) * 64 + lane] = vd; }
    __syncthreads();
    const float* ck = IN(2) + ((size_t)(l * 128 + b) * 128 * 2 + kvh) * 64; const float* cv = IN(3) + ((size_t)(l * 128 + b) * 128 * 2 + kvh) * 64;
    float s0 = 0.f, s1 = 0.f;
    {
        const float* k0 = ck + (size_t)(lane + 1) * 128; const float* k1 = (lane < 63) ? ck + (size_t)(lane + 65) * 128 : k0;
        {
            f32x4 ka[16];
#pragma unroll
            for (int d = 0; d < 16; ++d) ka[d] = *(const f32x4*)(k0 + 4 * d);
#pragma unroll
            for (int d = 0; d < 16; ++d) { const f32x4 qv = *(const LAS f32x4*)(qs + 4 * d); s0 += ka[d].x * qv.x + ka[d].y * qv.y + ka[d].z * qv.z + ka[d].w * qv.w; }
        }
        asm volatile("" ::: "memory");
        {
            f32x4 kb[16];
#pragma unroll
            for (int d = 0; d < 16; ++d) kb[d] = *(const f32x4*)(k1 + 4 * d);
#pragma unroll
            for (int d = 0; d < 16; ++d) { const f32x4 qv = *(const LAS f32x4*)(qs + 4 * d); s1 += kb[d].x * qv.x + kb[d].y * qv.y + kb[d].z * qv.z + kb[d].w * qv.w; }
        }
        const float snew = wave_sum(qd * kd);
        if (lane == 63) s1 = snew;
    }
    s0 *= 0.125f; s1 *= 0.125f;
    const float sink = IN(9)[l * 8 + hq];
    const float mx = fmaxf(wave_max(fmaxf(s0, s1)), sink);
    const float p0 = __expf(s0 - mx), p1 = __expf(s1 - mx);
    const float sum = wave_sum(p0 + p1) + __expf(sink - mx);
    asm volatile("" ::: "memory");
    const int g4 = lane >> 4, d4 = (lane & 15) * 4;
    f32x4 o4 = (f32x4){0.f, 0.f, 0.f, 0.f};
#pragma unroll 1
    for (int i0 = 0; i0 < 32; i0 += 8) {
        f32x4 vv[8];
#pragma unroll
        for (int j = 0; j < 8; ++j) { const int x = 4 * (i0 + j) + g4; vv[j] = (f32x4){0.f, 0.f, 0.f, 0.f}; if (x < 127) vv[j] = *(const f32x4*)(cv + (size_t)(x + 1) * 128 + d4); }
#pragma unroll
        for (int j = 0; j < 8; ++j) { const int x = 4 * (i0 + j) + g4; const float p = __shfl(i0 < 16 ? p0 : p1, x & 63); o4 += vv[j] * p; }
    }
    { const float pn = __shfl(p1, 63); const float vn0 = __shfl(vd, d4), vn1 = __shfl(vd, d4 + 1), vn2 = __shfl(vd, d4 + 2), vn3 = __shfl(vd, d4 + 3);
      if (g4 == 0) o4 += (f32x4){vn0, vn1, vn2, vn3} * pn; }
#pragma unroll
    for (int e = 0; e < 4; ++e) { o4[e] += __shfl_xor(o4[e], 16); o4[e] += __shfl_xor(o4[e], 32); }
    if (lane < 16) { const float rs = 1.0f / sum; u32x2 wv; wv.x = pk2(o4.x * rs, o4.y * rs); wv.y = pk2(o4.z * rs, o4.w * rs);
        *(u32x2*)(WSP(bf16_t, WS_MIX) + (size_t)(MP + b) * DM + hq * 64 + d4) = wv; }
}
__device__ __forceinline__ void hgrn_sample_wave(const Ctx& C, int l, int wi) {
    const int b = wi >> 2, h = wi & 3, lane = C.lane;
    const bf16_t* rp = WSP(bf16_t, WS_PROJ) + (size_t)(MP + b) * DIN;
    const float lbv = hgrn_lb(C, l, h * 64 + lane);
    const float f = lbv + (1.0f - lbv) * sigmoid_f(bf2f(rp[1536 + h * 64 + lane])), kk = 1.0f - f;
    const float q = bf2f(rp[1280 + h * 64 + lane]), iv = bf2f(rp[1792 + h * 64 + lane]), cg = bf2f(rp[2048 + h * 64 + lane]);
    const float* S0 = IN(4) + (size_t)((l * 128 + b) * 4 + h) * 4096; float* So = C.out + O_HSS + (size_t)((l * 128 + b) * 4 + h) * 4096;
    float o = 0.f;
#pragma unroll 16
    for (int k = 0; k < 64; ++k) { const float fk = __shfl(f, k), kkk = __shfl(kk, k), qk = __shfl(q, k);
        const float S = fk * S0[k * 64 + lane] + kkk * iv; So[k * 64 + lane] = S; o += qk * S; }
    const float ms = wave_sum(o * o) * (1.0f / 64.0f);
    const float y = o * (1.0f / sqrtf(ms + 1e-6f)) * IN(15)[l * 64 + lane] * silu2(cg);
    WSP(bf16_t, WS_MIX)[(size_t)(MP + b) * DM + 768 + h * 64 + lane] = (bf16_t)f2bf(y);
}
__device__ __forceinline__ void gmlp_sample_wave(const Ctx& C, int l, int b) {
    const int lane = C.lane, c = 4 * lane, g = c >> 6;
    const bf16_t* rp = WSP(bf16_t, WS_PROJ) + (size_t)(MP + b) * DIN;
    const u32x2 gw = *(const u32x2*)(rp + 1024 + c), uw = *(const u32x2*)(rp + 768 + c);
    float x[4] = {bf2f(gw.x & 0xffffu), bf2f(gw.x >> 16), bf2f(gw.y & 0xffffu), bf2f(gw.y >> 16)};
    const float u[4] = {bf2f(uw.x & 0xffffu), bf2f(uw.x >> 16), bf2f(uw.y & 0xffffu), bf2f(uw.y >> 16)};
    const float mean = wave_sum(x[0] + x[1] + x[2] + x[3]) * (1.0f / 256.0f);
    float sq = 0.f;
#pragma unroll
    for (int i = 0; i < 4; ++i) { x[i] -= mean; sq += x[i] * x[i]; }
    const float rstd = 1.0f / sqrtf(wave_sum(sq) * (1.0f / 256.0f) + 1e-5f);
    const float w00 = IN(12)[(size_t)(l * 4 + g) * 128 * 128], b0 = IN(13)[(l * 4 + g) * 128];
    float vn[4], y[4];
#pragma unroll
    for (int i = 0; i < 4; ++i) { vn[i] = x[i] * rstd * IN(10)[l * 256 + c + i] + IN(11)[l * 256 + c + i]; y[i] = u[i] * (w00 * vn[i] + b0); }
    *(f32x4*)(C.out + O_GV + (size_t)(l * 128 + b) * 256 + c) = (f32x4){vn[0], vn[1], vn[2], vn[3]};
    u32x2 wv; wv.x = pk2(y[0], y[1]); wv.y = pk2(y[2], y[3]);
    *(u32x2*)(WSP(bf16_t, WS_MIX) + (size_t)(MP + b) * DM + 512 + c) = wv;
}

__device__ __forceinline__ void sample_gemm(const Ctx& C, const bf16_t* A, int K, const bf16_t* Bt) {
    int lane = C.lane; asm volatile("" : "+v"(lane));
    const int fr = lane & 15, fq = lane >> 4, kl = K >> 2;
    for (int it = C.bid; it < 256; it += C.G) {
        const int cgp = it & 63, ks = it >> 6;
        const bf16_t* ap = A + (size_t)(C.wave * 16 + fr) * K + ks * kl + fq * 8; const bf16_t* bp = Bt + (size_t)(cgp * 16 + fr) * K + ks * kl + fq * 8;
        f32x4 acc = (f32x4){0.f, 0.f, 0.f, 0.f};
        if (kl == 704) {
#pragma unroll 1
            for (int s0 = 0; s0 < 704; s0 += 352) { bf16x8 av[11], bv[11];
#pragma unroll
                for (int j = 0; j < 11; ++j) { av[j] = *(const bf16x8*)(ap + s0 + 32 * j); bv[j] = *(const bf16x8*)(bp + s0 + 32 * j); }
#pragma unroll
                for (int j = 0; j < 11; ++j) acc = __builtin_amdgcn_mfma_f32_16x16x32_bf16(av[j], bv[j], acc, 0, 0, 0); }
        } else {
#pragma unroll 8
            for (int s = 0; s < kl; s += 32) acc = __builtin_amdgcn_mfma_f32_16x16x32_bf16(*(const bf16x8*)(ap + s), *(const bf16x8*)(bp + s), acc, 0, 0, 0);
        }
        float* yo = WSP(float, WS_YS) + ((size_t)ks * 128 + C.wave * 16 + fq * 4) * DM + cgp * 16 + fr;
#pragma unroll
        for (int i = 0; i < 4; ++i) yo[(size_t)i * DM] = acc[i];
    }
}

#define FRESH_CTX(C2, C) Ctx C2 = (C); { int z2_; asm volatile("s_mov_b32 %0, 0" : "=s"(z2_)); C2.ws = (C).ws + z2_; C2.out = (C).out + z2_; C2.in = (C).in + z2_; }
#ifndef XMODE
#define XMODE 0
#endif
__device__ __forceinline__ void phase_mix1(const Ctx& C, int l, int rep = 0) {
    if (!rep) for (int it = C.bid; it < 256; it += C.G) { FRESH_CTX(C2, C); attn_prompt_item(C2, l, it); }
    for (int it = C.bid; it < 256; it += C.G) { FRESH_CTX(C2, C); hgrn_local_item(C2, l, it, rep ? XMODE : 0); }
}
__device__ __forceinline__ void phase_mix2(const Ctx& C, int l, int rep = 0) {
    if (rep == 0) hgrn_scan(C, l);
#ifndef T_AS
#define T_AS 1
#define T_GP 1
#define T_HS 1
#define T_GS 1
#endif
    if (T_AS) for (int it = C.bid; it < 128; it += C.G) attn_sample_item(C, l, it);
    if (T_GP) for (int it = C.bid; it < 512; it += C.G) { FRESH_CTX(C2, C); gmlp_prompt_item(C2, l, it, (it != C.bid) && (C.G & 255) == 0); }
    if (T_HS) for (int it = (C.bid + 128) % C.G; it < 64; it += C.G) hgrn_sample_wave(C, l, it * 8 + C.wave);
    if (T_GS) for (int it = (C.bid + 64) % C.G; it < 16; it += C.G) gmlp_sample_wave(C, l, it * 8 + C.wave);
}
__device__ __forceinline__ void phase_mix3(const Ctx& C, int l) {
    for (int it = C.bid; it < 256; it += C.G) { FRESH_CTX(C2, C); hgrn_corr_item(C2, l, it); }
}

#define XB_TMO      128
#define XB_XCNT(j)  (256  + 64 * (j))
#define XB_XSUB(j)  (1280 + 64 * (j))
#define XB_XGEN(j)  (2304 + 64 * (j))
#define XB_TOP      3328
#define XB_TOPGEN   3392
#define XCD_BAR_WORDS 3456
#define XB_SPIN_CAP (1u << 18)

__device__ __forceinline__ unsigned xb_ld(unsigned* p)              { return __hip_atomic_load(p, __ATOMIC_RELAXED, __HIP_MEMORY_SCOPE_AGENT); }
__device__ __forceinline__ unsigned xb_add(unsigned* p, unsigned v) { return __hip_atomic_fetch_add(p, v, __ATOMIC_RELAXED, __HIP_MEMORY_SCOPE_AGENT); }
__device__ __forceinline__ unsigned xb_xcc_id() { return (unsigned)__builtin_amdgcn_s_getreg((3 << 11) | 20) & 0xFu; }
#define XB_SPIN(cond, bar) do { unsigned _sp = 0; while (cond) { __builtin_amdgcn_s_sleep(1); \
    if ((++_sp & 255u) == 0u) { if (xb_ld(&(bar)[XB_TMO])) break; if (_sp > XB_SPIN_CAP) { atomicAdd(&(bar)[XB_TMO], 1u); break; } } } } while (0)

struct XcdBarrier {
    unsigned* bar; unsigned x;
    volatile LAS unsigned* st;
};

__device__ __forceinline__ XcdBarrier xcd_barrier_post(unsigned* bar, volatile LAS unsigned* st) {
    XcdBarrier b; b.bar = bar; b.x = xb_xcc_id(); b.st = st;
    if (threadIdx.x == 0) (void)xb_add(&bar[XB_XCNT(b.x)], 1u);
    return b;
}
__device__ __forceinline__ void xcd_barrier_complete(unsigned* bar, unsigned x, unsigned& nloc, unsigned& nx) {
    const unsigned G = gridDim.x * gridDim.y * gridDim.z;
    unsigned sum, cnt, mine, sp = 0u;
    for (;;) {
        sum = 0u; cnt = 0u; mine = 0u;
#pragma unroll
        for (unsigned j = 0; j < 16; ++j) { const unsigned c = xb_ld(&bar[XB_XCNT(j)]); sum += c; cnt += (c > 0u) ? 1u : 0u; mine = (j == x) ? c : mine; }
        if (sum == G) break;
        __builtin_amdgcn_s_sleep(1);
        if ((++sp & 255u) == 0u) { if (xb_ld(&bar[XB_TMO])) break; if (sp > XB_SPIN_CAP) { atomicAdd(&bar[XB_TMO], 1u); break; } }
    }
    nloc = mine > 0u ? mine : 1u; nx = cnt > 0u ? cnt : 1u;
}

__device__ __forceinline__ void xcd_barrier(const XcdBarrier& b) {
    asm volatile("s_waitcnt vmcnt(0)" ::: "memory");
    __syncthreads();
    if (threadIdx.x == 0) {
        unsigned* bar = b.bar;
        __builtin_amdgcn_s_waitcnt(0);
        unsigned nloc = b.st[0], nx = b.st[1];
        if (nloc == 0u) { xcd_barrier_complete(bar, b.x, nloc, nx); b.st[0] = nloc; b.st[1] = nx; }
        const unsigned old = xb_add(&bar[XB_XSUB(b.x)], 1u);
        const unsigned gen = old / nloc;
        if (old + 1u == (gen + 1u) * nloc) {
            __builtin_amdgcn_fence(__ATOMIC_RELEASE, "agent");
            asm volatile("s_waitcnt vmcnt(0)" ::: "memory");
            const unsigned og = xb_add(&bar[XB_TOP], 1u);
            const unsigned tg = og / nx;
            if (og + 1u == (tg + 1u) * nx) xb_add(&bar[XB_TOPGEN], 1u);
            else XB_SPIN(xb_ld(&bar[XB_TOPGEN]) == tg, bar);
            __builtin_amdgcn_fence(__ATOMIC_ACQUIRE, "agent");
            xb_add(&bar[XB_XGEN(b.x)], 1u);
            asm volatile("s_waitcnt vmcnt(0)" ::: "memory");
        } else {
            XB_SPIN(xb_ld(&bar[XB_XGEN(b.x)]) == gen, bar);
            __builtin_amdgcn_fence(__ATOMIC_ACQUIRE, "agent");
            asm volatile("s_waitcnt vmcnt(0)" ::: "memory");
        }
    }
    __syncthreads();
}

#ifndef T_PRO
#define T_PRO 1
#endif
#ifndef T_G1
#define T_G1 1
#endif
#ifndef T_G2
#define T_G2 1
#endif
#ifndef T_G3
#define T_G3 1
#endif
#ifndef T_M1
#define T_M1 1
#endif
#ifndef T_M2
#define T_M2 1
#endif
#ifndef T_M3
#define T_M3 1
#endif
__global__ void __launch_bounds__(512, 2) mega_fwd(Args args) {
    extern __shared__ __attribute__((aligned(16))) unsigned char lds[];
    Ctx C;
    C.lds = (LAS unsigned char*)lds; C.tid = threadIdx.x; C.lane = C.tid & 63; C.wave = __builtin_amdgcn_readfirstlane(C.tid >> 6);
    C.G = gridDim.x; C.bid = blockIdx.x; C.in = args.in; C.out = args.out; C.ws = args.ws;
    cg::grid_group grid = cg::this_grid();
    volatile LAS unsigned* bst = (volatile LAS unsigned*)(C.lds + LDS_BYTES - 64);
    if (C.tid < 2) bst[C.tid] = 0u;
    __syncthreads();
    const XcdBarrier xbar = xcd_barrier_post((unsigned*)(args.ws + 16384), bst);
    const Ctx C0 = C;
#ifndef XDUP
#define XDUP (-1)
#endif
#ifndef XDUPN
#define XDUPN 1
#endif
    for (int pi_ = args.ph_lo; pi_ < args.ph_hi + (XDUP >= 0 ? XDUPN : 0); ++pi_) {
        int ph = pi_, XR_ = 0;
        if (XDUP >= 0 && pi_ >= XDUP) { const int o_ = pi_ - XDUP; if (o_ < 2 * XDUPN) { ph = XDUP + (o_ >> 1); XR_ = o_ & 1; } else ph = pi_ - XDUPN; }
        {
            int z_; int t_ = C0.tid;
            asm volatile("s_mov_b32 %0, 0" : "=s"(z_)); asm volatile("" : "+v"(t_));
            C.ws = C0.ws + z_; C.out = C0.out + z_; C.in = C0.in + z_; C.tid = t_; C.lane = t_ & 63;
        }
        if (ph == 0) { if (T_PRO) phase_prologue(C, XR_); }
        else if (ph == 1) phase_mod0(C);
        else {
            const int l = (ph - 2) / 12, s = (ph - 2) % 12;
            if (T_G1 && (s == 0 || s == 9 || s == 1 || s == 10 || s == 7 || s == 3)) {
                const int f2 = (s >= 9) ? 1 : 0, mi = l * 2 + f2;
                pg8::Gemm g; pg8::EpiMulti E; E.O = nullptr; E.ldc = 0; E.X = nullptr; E.Xw = nullptr; E.gate = nullptr; E.scale = 0.f; E.Xf = nullptr; E.ST = nullptr; E.pg = nullptr; E.pb = nullptr;
                { const int li = l * 3 + (s == 1 ? 0 : s == 7 ? 1 : 2);
                  if (s == 1 || s == 7 || s == 10) { if (li == 0) E.Xf = IN(0); else { E.ST = WSP(float, WS_ST); E.pg = IN(22) + (size_t)(li - 1) * DM; E.pb = IN(23) + (size_t)(li - 1) * DM; } } }
                if (s == 0 || s == 9) {
                    g = pg8::Gemm{WSP(pg8::bf16_t, WS_H), WSP(pg8::bf16_t, WS_FFIN) + (size_t)mi * 2 * DFF * DM, MPAD, 2 * DFF, DM};
                    E.mode = 0; E.O = WSP(pg8::bf16_t, WS_ACT); E.ldc = DFF;
                } else if (s == 1 || s == 10) {
                    g = pg8::Gemm{WSP(pg8::bf16_t, WS_ACT), WSP(pg8::bf16_t, WS_FFOUT) + (size_t)mi * DM * DFF, MP, DM, DFF};
                    E.mode = 2; E.X = WSP(pg8::bf16_t, WS_XB); E.gate = WSP(float, WS_MOD) + (size_t)l * NCROW * MODW + (size_t)(s == 1 ? 2 : 8) * DM; E.scale = 0.5f;
                } else if (s == 7) {
                    g = pg8::Gemm{WSP(pg8::bf16_t, WS_MIX), WSP(pg8::bf16_t, WS_WOUT) + (size_t)l * DM * DM, MP, DM, DM};
                    E.mode = 2; E.X = WSP(pg8::bf16_t, WS_XB); E.gate = WSP(float, WS_MOD) + (size_t)l * NCROW * MODW + (size_t)5 * DM; E.scale = 1.0f;
                } else {
                    g = pg8::Gemm{WSP(pg8::bf16_t, WS_H), WSP(pg8::bf16_t, WS_WIN) + (size_t)l * DIN * DM, MPAD, DIN, DM};
                    E.mode = 1; E.O = WSP(pg8::bf16_t, WS_PROJ); E.ldc = DIN;
                }
                E.Xw = XR_ ? (pg8::bf16_t*)(C.ws + 273 * MiB) : E.X;
                pg8::StaticOrder S; S.init(g.M, g.N, C.G, C.bid);
                pg8::gemm_phase<pg8::EpiMulti, pg8::StaticOrder, true, true>(C.lds, g, S, E);
                if (E.mode == 2) sample_gemm(C, g.A + (size_t)MP * g.K, g.K, g.Bt);
            } else if (s == 2) phase_ln(C, l, 0, XR_);
            else if (s == 8) phase_ln(C, l, 1, XR_);
            else if (s == 11) phase_ln(C, l, 2, (l == 1) ? 0 : XR_);
            else if (s == 4) { if (T_M1) phase_mix1(C, l, XR_); }
            else if (s == 5) { if (T_M2) phase_mix2(C, l, XR_); }
            else { if (T_M3) phase_mix3(C, l); }
        }
        if (pi_ + 1 < args.ph_hi + (XDUP >= 0 ? XDUPN : 0)) { if (args.ph_lo < 0) grid.sync(); else xcd_barrier(xbar); }
    }
}

#ifndef MK_ONE_LAUNCH
#define MK_ONE_LAUNCH 1
#endif
extern "C" void kernel_launch(void* const* d_in, const int* in_sizes, int n_in, void* d_out, int out_size, void* d_ws, size_t ws_size, hipStream_t stream) {
    static int grid = 0;
    if (grid == 0) {
        if (n_in != 24 || ws_size < WS_END) { fprintf(stderr, "kernel_launch: unexpected n_in %d / ws %zu\n", n_in, ws_size); grid = -1; return; }
        int dev = 0, cus = 0, per_cu = 0;
        (void)hipGetDevice(&dev); (void)hipDeviceGetAttribute(&cus, hipDeviceAttributeMultiprocessorCount, dev);
        if (hipFuncSetAttribute((const void*)mega_fwd, hipFuncAttributeMaxDynamicSharedMemorySize, LDS_BYTES) != hipSuccess) { fprintf(stderr, "kernel_launch: hipFuncSetAttribute failed\n"); grid = -1; return; }
        if (hipOccupancyMaxActiveBlocksPerMultiprocessor(&per_cu, (const void*)mega_fwd, 512, LDS_BYTES) != hipSuccess || per_cu < 1) { fprintf(stderr, "kernel_launch: occupancy query gave %d\n", per_cu); per_cu = 1; }
        (void)hipGetLastError();
        grid = cus > 0 ? cus : 256;
    }
    if (grid < 0) return;
    (void)hipMemsetAsync(d_ws, 0, 65536, stream);
    Args a{};
    for (int i = 0; i < 24; ++i) a.in[i] = (const float*)d_in[i];
    a.out = (float*)d_out; a.ws = (unsigned char*)d_ws;
#if MK_ONE_LAUNCH
    a.ph_lo = 0; a.ph_hi = NPH;
    void* kargs[] = {&a};
    hipError_t e = hipLaunchCooperativeKernel((const void*)mega_fwd, dim3(grid), dim3(512), kargs, LDS_BYTES, stream);
    if (e != hipSuccess) fprintf(stderr, "kernel_launch: cooperative launch failed: %s (grid %d)\n", hipGetErrorString(e), grid);
#else
    for (int ph = 0; ph < NPH; ++ph) { a.ph_lo = ph; a.ph_hi = ph + 1; hipLaunchKernelGGL(mega_fwd, dim3(grid), dim3(512), LDS_BYTES, stream, a); }
#endif
}
```
